# Optimizing an MI355X kernel written in HIP

```python
import math
import jax, jax.numpy as jnp
from jax import lax
import numpy as np

D_MODEL = 1024
BATCH = 16
SEQ = 256
DEPTH = 4
DEC_BATCH = 4
DEC_SEQ = 1024
PAST_LEN = 256

GRID_W = 64
EPS = 1e-6
D_HY = 512
HY_SHORT = 3
N_BANDS = 8
FILT_EMB = 1 + 2 * N_BANDS
FILT_HID = 64
DECAY_SLOW = -math.log(1e-2) / 1.5
DECAY_FAST = -math.log(1e-2) / 0.3
D_FN = 512
N_FN_GROUPS = 4
FN_GROUP = D_FN // N_FN_GROUPS
D_RG = 1024
N_RG_BLOCKS = 8
RG_BLOCK = D_RG // N_RG_BLOCKS
RG_CONV = 4
RG_C = 8.0
D_FF = -(-8 * D_MODEL // (3 * 256)) * 256
D_IN = 3 * D_HY + D_FN + 2 * D_RG + 3 * D_MODEL
SPLITS = (3 * D_HY, 3 * D_HY + D_FN, 3 * D_HY + D_FN + D_RG, 3 * D_HY + D_FN + 2 * D_RG)

kernel_name = 'hybrid_hyena_fnet_rglru_prefix_step'


def rmsnorm(x, g):
    xf = x.astype(jnp.float32)
    y = xf * lax.rsqrt(jnp.mean(xf * xf, axis=-1, keepdims=True) + EPS)
    return (y * g.astype(jnp.float32)).astype(x.dtype)


def depthwise_conv(x, w, b, pad_l, pad_r):
    L = x.shape[1]
    xp = jnp.pad(x, ((0, 0), (pad_l, pad_r), (0, 0)))
    out = b
    for k in range(w.shape[0]):
        out = out + xp[:, k:k + L] * w[k]
    return out


def hyena_filters(L, fw1, fb1, fw2, fb2, fw3, ffreq):
    f32 = jnp.float32
    t = jnp.arange(L, dtype=f32) / L
    ang = 2.0 * math.pi * t[:, None] * jnp.arange(1, N_BANDS + 1, dtype=f32)
    feats = jnp.concatenate([t[:, None], jnp.sin(ang), jnp.cos(ang)], axis=-1)
    freq = ffreq.astype(f32)
    h = jnp.sin(freq * (feats @ fw1.astype(f32) + fb1.astype(f32)))
    h = jnp.sin(freq * (h @ fw2.astype(f32) + fb2.astype(f32)))
    h = (h @ fw3.astype(f32)).reshape(L, 2, 2, D_HY)
    deltas = jnp.linspace(DECAY_SLOW, DECAY_FAST, D_HY, dtype=f32)
    h = h * jnp.exp(-t[:, None] * deltas)[:, None, None, :]
    fwd = h[:, :, 0]
    bwd = h[1:, :, 1][::-1]
    k = jnp.concatenate([fwd, jnp.zeros((1, 2, D_HY), f32), bwd], axis=0)
    k = k * lax.rsqrt(jnp.sum(k * k, axis=0, keepdims=True) + EPS)
    return jnp.fft.rfft(k, axis=0)


def fft_conv(z, kf):
    L = z.shape[1]
    zf = jnp.fft.rfft(z, n=2 * L, axis=1)
    return jnp.fft.irfft(zf * kf, n=2 * L, axis=1)[:, :L]


def hyena_branch(u, conv_w, conv_b, kf, bias):
    u = depthwise_conv(u, conv_w, conv_b, HY_SHORT // 2, HY_SHORT - 1 - HY_SHORT // 2).astype(jnp.float32)
    v, x1, x2 = jnp.split(u, 3, axis=-1)
    bias = bias.astype(jnp.float32)
    z = x1 * (fft_conv(v, kf[:, 0]) + bias[0] * v)
    z = x2 * (fft_conv(z, kf[:, 1]) + bias[1] * z)
    return z


def fnet_branch(u):
    B, L, _ = u.shape
    g = u.astype(jnp.float32).reshape(B, L, N_FN_GROUPS, FN_GROUP)
    return jnp.real(jnp.fft.fft2(g, axes=(1, 3), norm='ortho')).reshape(B, L, D_FN)


def _lin_combine(e1, e2):
    a1, b1 = e1
    a2, b2 = e2
    return a1 * a2, a2 * b1 + b2


def rglru_scan(x, w_r, b_r, w_i, b_i, lam, h0, reverse, reset):
    f32 = jnp.float32
    B, L, _ = x.shape
    xb = x.reshape(B, L, N_RG_BLOCKS, RG_BLOCK)
    r = jax.nn.sigmoid(jnp.einsum('blnc,ncd->blnd', xb, w_r.astype(f32)).reshape(B, L, D_RG) + b_r.astype(f32))
    i = jax.nn.sigmoid(jnp.einsum('blnc,ncd->blnd', xb, w_i.astype(f32)).reshape(B, L, D_RG) + b_i.astype(f32))
    log_a = -RG_C * r * jax.nn.softplus(-lam.astype(f32))
    a = jnp.exp(log_a)
    mult = jnp.sqrt(-jnp.expm1(2.0 * log_a))
    if reset:
        mult = mult.at[:, L - 1 if reverse else 0].set(1.0)
    A, Bc = lax.associative_scan(_lin_combine, (a, mult * (i * x)), axis=1, reverse=reverse)
    h = Bc + A * h0[:, None, :]
    final = h[:, 0] if reverse else h[:, -1]
    return h, final


def trunk_layer(x, mod, rg_h0, reset, lp):
    (n1, n2, w_in, hcw, hcb, fw1, fb1, fw2, fb2, fw3, ffreq, hbias, w_a, w_b,
     rcw, rcb, wr, br, wi, bi, lam, w_c, w_o, w_gu, w_down) = lp
    dt = x.dtype
    L = x.shape[1]
    sh1, sc1, g1, sh2, sc2, g2 = jnp.split(mod[:, None, :].astype(dt), 6, axis=-1)
    h = rmsnorm(x, n1) * (1 + sc1) + sh1
    u = h @ w_in
    u_hy, u_fn, u_rx, u_ry, u_g = jnp.split(u, SPLITS, axis=-1)
    kf = hyena_filters(L, fw1, fb1, fw2, fb2, fw3, ffreq)
    y_a = hyena_branch(u_hy, hcw, hcb, kf, hbias).astype(dt) @ w_a
    y_b = fnet_branch(u_fn).astype(dt) @ w_b
    xr = depthwise_conv(u_rx, rcw, rcb, RG_CONV // 2, RG_CONV - 1 - RG_CONV // 2).astype(jnp.float32)
    h_f, s_f = rglru_scan(xr, wr[0], br[0], wi[0], bi[0], lam[0], rg_h0[:, 0], False, reset)
    h_b, s_b = rglru_scan(xr, wr[1], br[1], wi[1], bi[1], lam[1], rg_h0[:, 1], True, reset)
    y_c = ((h_f + h_b).astype(dt) * jax.nn.gelu(u_ry)) @ w_c
    ga, gb, gc = jnp.split(jax.nn.sigmoid(u_g), 3, axis=-1)
    x = x + g1 * ((ga * y_a + gb * y_b + gc * y_c) @ w_o)
    h = rmsnorm(x, n2) * (1 + sc2) + sh2
    gt, up = jnp.split(h @ w_gu, 2, axis=-1)
    x = x + g2 * ((jax.nn.silu(gt) * up) @ w_down)
    return x, jnp.stack([s_f, s_b], axis=1)


def setup_inputs(seed: int = 0) -> dict:
    key = jax.random.key(seed)
    ks = iter(jax.random.split(key, 48))

    def nrm(shape, scale):
        return jax.random.normal(next(ks), shape, jnp.float32) * scale

    D = D_MODEL
    lam_u = jax.random.uniform(next(ks), (DEPTH, 2, D_RG), jnp.float32, 0.9, 0.999)
    return {
        'x_prompt': nrm((BATCH, SEQ, D), 1.0),
        'x_sample': nrm((DEC_BATCH, DEC_SEQ, D), 1.0),
        'c': nrm((DEC_BATCH, D), 1.0),
        'state_rglru': nrm((DEC_BATCH, DEPTH, 2, D_RG), 0.5),
        'c_ctx': nrm((D,), 1.0),
        'norm1_g': 1.0 + nrm((DEPTH, D), 0.02),
        'norm2_g': 1.0 + nrm((DEPTH, D), 0.02),
        'w_ada': nrm((DEPTH, D, 6 * D), 0.5 * D ** -0.5),
        'b_ada': nrm((DEPTH, 6 * D), 0.01),
        'w_in': nrm((DEPTH, D, D_IN), D ** -0.5),
        'hy_conv_w': nrm((DEPTH, HY_SHORT, 3 * D_HY), HY_SHORT ** -0.5),
        'hy_conv_b': nrm((DEPTH, 3 * D_HY), 0.01),
        'hy_f_w1': nrm((DEPTH, FILT_EMB, FILT_HID), FILT_EMB ** -0.5),
        'hy_f_b1': nrm((DEPTH, FILT_HID), 0.1),
        'hy_f_w2': nrm((DEPTH, FILT_HID, FILT_HID), FILT_HID ** -0.5),
        'hy_f_b2': nrm((DEPTH, FILT_HID), 0.1),
        'hy_f_w3': nrm((DEPTH, FILT_HID, 4 * D_HY), FILT_HID ** -0.5),
        'hy_f_freq': 1.0 + nrm((DEPTH, FILT_HID), 0.1),
        'hy_bias': nrm((DEPTH, 2, D_HY), 0.1),
        'w_a': nrm((DEPTH, D_HY, D), D_HY ** -0.5),
        'w_b': nrm((DEPTH, D_FN, D), D_FN ** -0.5),
        'rg_conv_w': nrm((DEPTH, RG_CONV, D_RG), RG_CONV ** -0.5),
        'rg_conv_b': nrm((DEPTH, D_RG), 0.01),
        'rg_wr': nrm((DEPTH, 2, N_RG_BLOCKS, RG_BLOCK, RG_BLOCK), RG_BLOCK ** -0.5),
        'rg_br': nrm((DEPTH, 2, D_RG), 0.01),
        'rg_wi': nrm((DEPTH, 2, N_RG_BLOCKS, RG_BLOCK, RG_BLOCK), RG_BLOCK ** -0.5),
        'rg_bi': nrm((DEPTH, 2, D_RG), 0.01),
        'rg_lam': jnp.log(lam_u) - jnp.log1p(-lam_u),
        'w_c': nrm((DEPTH, D_RG, D), D_RG ** -0.5),
        'w_o': nrm((DEPTH, D, D), D ** -0.5),
        'w_gu': nrm((DEPTH, D, 2 * D_FF), D ** -0.5),
        'w_down': nrm((DEPTH, D_FF, D), D_FF ** -0.5),
        'final_g': 1.0 + nrm((D,), 0.02),
    }


def reference(x_prompt, x_sample, c, state_rglru, c_ctx, norm1_g, norm2_g, w_ada, b_ada, w_in,
              hy_conv_w, hy_conv_b, hy_f_w1, hy_f_b1, hy_f_w2, hy_f_b2, hy_f_w3, hy_f_freq, hy_bias,
              w_a, w_b, rg_conv_w, rg_conv_b, rg_wr, rg_br, rg_wi, rg_bi, rg_lam, w_c, w_o,
              w_gu, w_down, final_g):
    xp = x_prompt
    xs = x_sample
    ctx_states = []
    for l in range(DEPTH):
        lp = (norm1_g[l], norm2_g[l], w_in[l], hy_conv_w[l], hy_conv_b[l], hy_f_w1[l], hy_f_b1[l],
              hy_f_w2[l], hy_f_b2[l], hy_f_w3[l], hy_f_freq[l], hy_bias[l], w_a[l], w_b[l],
              rg_conv_w[l], rg_conv_b[l], rg_wr[l], rg_br[l], rg_wi[l], rg_bi[l], rg_lam[l],
              w_c[l], w_o[l], w_gu[l], w_down[l])
        mod_ctx = jax.nn.silu(c_ctx[None, :]) @ w_ada[l] + b_ada[l]
        mod_lat = jax.nn.silu(c) @ w_ada[l] + b_ada[l]
        xp, st = trunk_layer(xp, mod_ctx, jnp.zeros((xp.shape[0], 2, D_RG), jnp.float32), True, lp)
        ctx_states.append(st)
        xs, _ = trunk_layer(xs, mod_lat, state_rglru[:, l].astype(jnp.float32), False, lp)
    y_prompt = rmsnorm(xp, final_g)
    y_sample = rmsnorm(xs, final_g)
    new_state_rglru = jnp.stack(ctx_states, axis=1).astype(x_prompt.dtype)
    return (y_prompt, y_sample, new_state_rglru)
```

```cpp
#include <hip/hip_runtime.h>
#include <cstdint>
#include <cstdio>
#include <cmath>

constexpr int D = 1024, DEPTH = 4;
constexpr int NCTX = 16, LCTX = 256, NLAT = 4, LLAT = 1024;
constexpr int MCTX = NCTX * LCTX, MLAT = NLAT * LLAT, MTOK = MCTX + MLAT;
constexpr int DHY = 512, DFN = 512, DRG = 1024, DFF = 2816, DIN = 7168;
constexpr int OFF_HY = 0, OFF_FN = 1536, OFF_RX = 2048, OFF_RY = 3072, OFF_G = 4096;
constexpr int NMOD = 6 * D;
constexpr float EPS = 1e-6f;
constexpr float DECAY_SLOW = 3.0701134573253945f;
constexpr float DECAY_FAST = 15.350567286626972f;

typedef short bf16x8 __attribute__((ext_vector_type(8)));
typedef float f32x4 __attribute__((ext_vector_type(4)));
typedef unsigned short bf16_t;

__device__ __forceinline__ bf16_t f2bf(float f) { unsigned u = __float_as_uint(f); return (bf16_t)((u + 0x7fffu + ((u >> 16) & 1u)) >> 16); }
__device__ __forceinline__ float bf2f(bf16_t h) { return __uint_as_float(((unsigned)h) << 16); }
__device__ __forceinline__ float sigmoidf_(float x) { return 1.f / (1.f + __expf(-x)); }
__device__ __forceinline__ float siluf_(float x) { return x / (1.f + __expf(-x)); }
__device__ __forceinline__ float gelu_tanh(float x) { const float u = 0.7978845608028654f * (x + 0.044715f * x * x * x); return 0.5f * x * (1.f + tanhf(u)); }

struct RowInfo { int grp, t, L, s0, lset, frow; };
__device__ __forceinline__ RowInfo rowinfo(int m) {
    RowInfo r;
    if (m < MCTX) { r.grp = 0; r.t = m & 255; r.L = LCTX; r.s0 = m - r.t; r.lset = 0; r.frow = 0; }
    else { const int mm = m - MCTX; r.grp = 1 + (mm >> 10); r.t = mm & 1023; r.L = LLAT; r.s0 = m - r.t; r.lset = 1; r.frow = 256; }
    return r;
}

__global__ void k_mod(const float* __restrict__ c, const float* __restrict__ c_ctx, const float* __restrict__ w_ada, const float* __restrict__ b_ada, float* __restrict__ mod) {
    const int idx = blockIdx.x * 256 + threadIdx.x; if (idx >= DEPTH * 5 * NMOD) return;
    const int n = idx % NMOD, g = (idx / NMOD) % 5, l = idx / (NMOD * 5);
    const float* cv = g == 0 ? c_ctx : c + (g - 1) * D;
    float acc = 0.f;
    for (int k = 0; k < D; ++k) { acc += siluf_(cv[k]) * w_ada[((size_t)l * D + k) * NMOD + n]; }
    mod[idx] = acc + b_ada[l * NMOD + n];
}

__global__ void k_filt_h2(const float* __restrict__ fw1, const float* __restrict__ fb1, const float* __restrict__ fw2, const float* __restrict__ fb2, const float* __restrict__ ffreq, float* __restrict__ h2) {
    __shared__ float feats[17]; __shared__ float h1[64];
    const int r = blockIdx.x, j = threadIdx.x;
    const int L = r < 256 ? 256 : 1024; const int ti = r < 256 ? r : r - 256;
    const float t = (float)ti / (float)L;
    if (j < 17) {
        float f;
        if (j == 0) f = t;
        else if (j <= 8) f = sinf(6.283185307179586f * t * (float)j);
        else f = cosf(6.283185307179586f * t * (float)(j - 8));
        feats[j] = f;
    }
    __syncthreads();
    float a = fb1[j];
    for (int k = 0; k < 17; ++k) a += feats[k] * fw1[k * 64 + j];
    h1[j] = sinf(ffreq[j] * a);
    __syncthreads();
    float b = fb2[j];
    for (int k = 0; k < 64; ++k) b += h1[k] * fw2[k * 64 + j];
    h2[r * 64 + j] = sinf(ffreq[j] * b);
}
__global__ void k_filt_h3(const float* __restrict__ h2, const float* __restrict__ fw3, float* __restrict__ kraw) {
    const int idx = blockIdx.x * 256 + threadIdx.x; if (idx >= 1280 * 2048) return;
    const int j = idx & 2047, r = idx >> 11;
    const int L = r < 256 ? 256 : 1024; const int ti = r < 256 ? r : r - 256;
    const float t = (float)ti / (float)L;
    float acc = 0.f;
    for (int k = 0; k < 64; ++k) acc += h2[r * 64 + k] * fw3[k * 2048 + j];
    const int c = j & 511;
    const float delta = DECAY_SLOW + (DECAY_FAST - DECAY_SLOW) * ((float)c / 511.0f);
    kraw[idx] = acc * expf(-t * delta);
}
__global__ void k_filt_norm(const float* __restrict__ kraw, float* __restrict__ scale) {
    const int idx = blockIdx.x * 256 + threadIdx.x; if (idx >= 2 * 2 * 512) return;
    const int c = idx & 511, o = (idx >> 9) & 1, ls = idx >> 10;
    const int L = ls ? 1024 : 256, r0 = ls ? 256 : 0;
    float s = 0.f;
    for (int t = 0; t < L; ++t) { const float f = kraw[(size_t)(r0 + t) * 2048 + o * 1024 + c]; s += f * f; if (t >= 1) { const float b = kraw[(size_t)(r0 + t) * 2048 + o * 1024 + 512 + c]; s += b * b; } }
    scale[idx] = rsqrtf(s + EPS);
}

__global__ void k_norm(const float* __restrict__ x, const float* __restrict__ gw, const float* __restrict__ modl, int sh_off, int sc_off, float* __restrict__ h) {
    const int m = blockIdx.x * 4 + (threadIdx.x >> 6), lane = threadIdx.x & 63;
    const RowInfo ri = rowinfo(m);
    const float* xr = x + (size_t)m * D;
    float s = 0.f;
    for (int i = 0; i < 16; ++i) { const float v = xr[lane + 64 * i]; s += v * v; }
    for (int o = 1; o < 64; o <<= 1) s += __shfl_xor(s, o);
    const float rs = rsqrtf(s * (1.f / D) + EPS);
    const float* mg = modl + ri.grp * NMOD;
    for (int i = 0; i < 16; ++i) { const int k = lane + 64 * i; h[(size_t)m * D + k] = xr[k] * rs * gw[k] * (1.f + mg[sc_off + k]) + mg[sh_off + k]; }
}
__global__ void k_final(const float* __restrict__ x, const float* __restrict__ gw, float* __restrict__ out) {
    const int m = blockIdx.x * 4 + (threadIdx.x >> 6), lane = threadIdx.x & 63;
    const float* xr = x + (size_t)m * D;
    float s = 0.f;
    for (int i = 0; i < 16; ++i) { const float v = xr[lane + 64 * i]; s += v * v; }
    for (int o = 1; o < 64; o <<= 1) s += __shfl_xor(s, o);
    const float rs = rsqrtf(s * (1.f / D) + EPS);
    for (int i = 0; i < 16; ++i) { const int k = lane + 64 * i; out[(size_t)m * D + k] = xr[k] * rs * gw[k]; }
}

template <class Epi>
__global__ __launch_bounds__(256) void k_gemm(const float* __restrict__ A, int lda, const float* __restrict__ B, int ldb, int K, Epi epi) {
    __shared__ __attribute__((aligned(16))) bf16_t As[128 * 40];
    __shared__ __attribute__((aligned(16))) bf16_t Bs[128 * 40];
    const int m0 = blockIdx.y * 128, n0 = blockIdx.x * 128;
    const int tid = threadIdx.x, lane = tid & 63, w = tid >> 6, wm = w >> 1, wn = w & 1, r16 = lane & 15, quad = lane >> 4;
    f32x4 acc[4][4];
#pragma unroll
    for (int i = 0; i < 4; ++i)
#pragma unroll
        for (int j = 0; j < 4; ++j) acc[i][j] = (f32x4){0.f, 0.f, 0.f, 0.f};
    for (int k0 = 0; k0 < K; k0 += 32) {
#pragma unroll
        for (int i = 0; i < 4; ++i) {
            const int idx = tid + i * 256, row = idx >> 3, c4 = idx & 7;
            const float4 v = *(const float4*)(A + (size_t)(m0 + row) * lda + k0 + c4 * 4);
            uint2 p; p.x = (unsigned)f2bf(v.x) | ((unsigned)f2bf(v.y) << 16); p.y = (unsigned)f2bf(v.z) | ((unsigned)f2bf(v.w) << 16);
            *(uint2*)&As[row * 40 + c4 * 4] = p;
        }
#pragma unroll
        for (int i = 0; i < 4; ++i) {
            const int idx = tid + i * 256, kk = idx >> 5, n4 = idx & 31;
            const float4 v = *(const float4*)(B + (size_t)(k0 + kk) * ldb + n0 + n4 * 4);
            Bs[(n4 * 4 + 0) * 40 + kk] = f2bf(v.x); Bs[(n4 * 4 + 1) * 40 + kk] = f2bf(v.y);
            Bs[(n4 * 4 + 2) * 40 + kk] = f2bf(v.z); Bs[(n4 * 4 + 3) * 40 + kk] = f2bf(v.w);
        }
        __syncthreads();
        bf16x8 a[4], b[4];
#pragma unroll
        for (int mt = 0; mt < 4; ++mt) a[mt] = *(const bf16x8*)&As[(wm * 64 + mt * 16 + r16) * 40 + quad * 8];
#pragma unroll
        for (int nt = 0; nt < 4; ++nt) b[nt] = *(const bf16x8*)&Bs[(wn * 64 + nt * 16 + r16) * 40 + quad * 8];
#pragma unroll
        for (int mt = 0; mt < 4; ++mt)
#pragma unroll
            for (int nt = 0; nt < 4; ++nt) acc[mt][nt] = __builtin_amdgcn_mfma_f32_16x16x32_bf16(a[mt], b[nt], acc[mt][nt], 0, 0, 0);
        __syncthreads();
    }
#pragma unroll
    for (int mt = 0; mt < 4; ++mt)
#pragma unroll
        for (int nt = 0; nt < 4; ++nt)
#pragma unroll
            for (int j = 0; j < 4; ++j) epi(m0 + wm * 64 + mt * 16 + quad * 4 + j, n0 + wn * 64 + nt * 16 + r16, acc[mt][nt][j]);
}
struct EpiBf16 { bf16_t* out; int ld; int pad; __device__ void operator()(int r, int c, float v) const { out[(size_t)r * ld + c] = f2bf(v); } };
struct EpiMerge { float* merged; const bf16_t* u; int which; int accum;
    __device__ void operator()(int r, int c, float v) const { const float g = sigmoidf_(bf2f(u[(size_t)r * DIN + OFF_G + which * D + c])); const float val = g * v; float* p = merged + (size_t)r * D + c; if (accum) *p += val; else *p = val; } };
struct EpiResid { float* x; const float* modl; int goff; int pad;
    __device__ void operator()(int r, int c, float v) const { const int grp = r < MCTX ? 0 : 1 + ((r - MCTX) >> 10); x[(size_t)r * D + c] += modl[grp * NMOD + goff + c] * v; } };

__global__ void k_hy_sconv(const bf16_t* __restrict__ u, const float* __restrict__ cw, const float* __restrict__ cb, float* __restrict__ uc) {
    const int idx = blockIdx.x * 256 + threadIdx.x; if (idx >= MTOK * 1536) return;
    const int j = idx % 1536, m = idx / 1536; const RowInfo ri = rowinfo(m);
    float a = cb[j];
    for (int k = 0; k < 3; ++k) { const int tt = ri.t + k - 1; if (tt >= 0 && tt < ri.L) a += bf2f(u[(size_t)(m + k - 1) * DIN + OFF_HY + j]) * cw[k * 1536 + j]; }
    uc[idx] = a;
}
__global__ void k_hy_conv(const float* __restrict__ zin, int ldz, const float* __restrict__ gate, int ldg, const float* __restrict__ kraw, const float* __restrict__ scale, const float* __restrict__ hbias, int o, float* __restrict__ out) {
    const int idx = blockIdx.x * 256 + threadIdx.x; if (idx >= MTOK * 512) return;
    const int c = idx & 511, m = idx >> 9; const RowInfo ri = rowinfo(m);
    float acc = 0.f;
    for (int s = 0; s < ri.L; ++s) {
        const int d = ri.t - s; const int ad = d < 0 ? -d : d; const int dir = d < 0 ? 1 : 0;
        acc += kraw[(size_t)(ri.frow + ad) * 2048 + o * 1024 + dir * 512 + c] * zin[(size_t)(ri.s0 + s) * ldz + c];
    }
    acc *= scale[(ri.lset * 2 + o) * 512 + c];
    out[idx] = gate[(size_t)m * ldg + c] * (acc + hbias[o * 512 + c] * zin[(size_t)m * ldz + c]);
}

__global__ void k_fnet_ch(const bf16_t* __restrict__ u, float* __restrict__ gc, float* __restrict__ gs) {
    const int idx = blockIdx.x * 256 + threadIdx.x; if (idx >= MTOK * 512) return;
    const int j = idx & 511, m = idx >> 9, g = j >> 7, c = j & 127;
    float ac = 0.f, as = 0.f;
    for (int cc = 0; cc < 128; ++cc) {
        float sn, cs; sincospif((float)((c * cc) & 127) * (2.0f / 128.0f), &sn, &cs);
        const float v = bf2f(u[(size_t)m * DIN + OFF_FN + g * 128 + cc]);
        ac += v * cs; as += v * sn;
    }
    gc[idx] = ac; gs[idx] = as;
}
__global__ void k_fnet_seq(const float* __restrict__ gc, const float* __restrict__ gs, float* __restrict__ out) {
    const int idx = blockIdx.x * 256 + threadIdx.x; if (idx >= MTOK * 512) return;
    const int j = idx & 511, m = idx >> 9; const RowInfo ri = rowinfo(m);
    float acc = 0.f;
    for (int l = 0; l < ri.L; ++l) {
        float sn, cs; sincospif((float)((l * ri.t) & (ri.L - 1)) * (2.0f / (float)ri.L), &sn, &cs);
        acc += cs * gc[(size_t)(ri.s0 + l) * 512 + j] - sn * gs[(size_t)(ri.s0 + l) * 512 + j];
    }
    out[idx] = acc * rsqrtf((float)ri.L * 128.0f);
}

__global__ void k_rg_conv(const bf16_t* __restrict__ u, const float* __restrict__ cw, const float* __restrict__ cb, float* __restrict__ xr) {
    const int idx = blockIdx.x * 256 + threadIdx.x; if (idx >= MTOK * DRG) return;
    const int ch = idx & 1023, m = idx >> 10; const RowInfo ri = rowinfo(m);
    float a = cb[ch];
    for (int k = 0; k < 4; ++k) { const int tt = ri.t + k - 2; if (tt >= 0 && tt < ri.L) a += bf2f(u[(size_t)(m + k - 2) * DIN + OFF_RX + ch]) * cw[k * 1024 + ch]; }
    xr[idx] = a;
}
__global__ void k_rg_gates(const float* __restrict__ xr, const float* __restrict__ wr, const float* __restrict__ br, const float* __restrict__ wi, const float* __restrict__ bi, const float* __restrict__ lam, int dir, float* __restrict__ ga, float* __restrict__ gb) {
    const int idx = blockIdx.x * 256 + threadIdx.x; if (idx >= MTOK * DRG) return;
    const int ch = idx & 1023, m = idx >> 10, n = ch >> 7, d = ch & 127; const RowInfo ri = rowinfo(m);
    const float* wrp = wr + ((size_t)(dir * 8 + n) * 128) * 128 + d;
    const float* wip = wi + ((size_t)(dir * 8 + n) * 128) * 128 + d;
    const float* xp = xr + (size_t)m * DRG + n * 128;
    float r = br[dir * 1024 + ch], i = bi[dir * 1024 + ch];
    for (int c = 0; c < 128; ++c) { const float xv = xp[c]; r += xv * wrp[c * 128]; i += xv * wip[c * 128]; }
    r = sigmoidf_(r); i = sigmoidf_(i);
    const float lm = lam[dir * 1024 + ch];
    const float sp = log1pf(expf(-lm));
    const float log_a = -8.0f * r * sp;
    const float a = expf(log_a);
    float mult = sqrtf(-expm1f(2.0f * log_a));
    if (ri.grp == 0 && ((dir == 0 && ri.t == 0) || (dir == 1 && ri.t == ri.L - 1))) mult = 1.0f;
    ga[idx] = a; gb[idx] = mult * i * xr[idx];
}
__global__ void k_rg_scan(const float* __restrict__ ga, const float* __restrict__ gb, const float* __restrict__ state, const bf16_t* __restrict__ u, int layer, int dir, float* __restrict__ zrg, float* __restrict__ new_state) {
    const int idx = blockIdx.x * 256 + threadIdx.x; if (idx >= 20 * DRG) return;
    const int ch = idx & 1023, seq = idx >> 10;
    int s0, L; float h;
    if (seq < NCTX) { s0 = seq * LCTX; L = LCTX; h = 0.f; }
    else { const int b = seq - NCTX; s0 = MCTX + b * LLAT; L = LLAT; h = state[((size_t)(b * DEPTH + layer) * 2 + dir) * DRG + ch]; }
    if (dir == 0) {
        for (int t = 0; t < L; ++t) { const size_t o = (size_t)(s0 + t) * DRG + ch; h = ga[o] * h + gb[o]; zrg[o] = h; }
    } else {
        for (int t = L - 1; t >= 0; --t) { const size_t o = (size_t)(s0 + t) * DRG + ch; h = ga[o] * h + gb[o];
            zrg[o] = (zrg[o] + h) * gelu_tanh(bf2f(u[(size_t)(s0 + t) * DIN + OFF_RY + ch])); }
    }
    if (seq < NCTX) new_state[((size_t)(seq * DEPTH + layer) * 2 + dir) * DRG + ch] = h;
}

__global__ void k_swiglu(const bf16_t* __restrict__ gu, float* __restrict__ hm) {
    const int idx = blockIdx.x * 256 + threadIdx.x; if (idx >= MTOK * DFF) return;
    const int j = idx % DFF, m = idx / DFF;
    hm[idx] = siluf_(bf2f(gu[(size_t)m * 2 * DFF + j])) * bf2f(gu[(size_t)m * 2 * DFF + DFF + j]);
}

static inline int cdiv(long a, long b) { return (int)((a + b - 1) / b); }

extern "C" void kernel_launch(void* const* d_in, const int* in_sizes, int n_in, void* d_out, int out_size, void* d_ws, size_t ws_size, hipStream_t stream) {
    const float* x_prompt = (const float*)d_in[0]; const float* x_sample = (const float*)d_in[1]; const float* cvec = (const float*)d_in[2];
    const float* state = (const float*)d_in[3]; const float* c_ctx = (const float*)d_in[4]; const float* n1g = (const float*)d_in[5]; const float* n2g = (const float*)d_in[6];
    const float* w_ada = (const float*)d_in[7]; const float* b_ada = (const float*)d_in[8]; const float* w_in = (const float*)d_in[9];
    const float* hcw = (const float*)d_in[10]; const float* hcb = (const float*)d_in[11]; const float* fw1 = (const float*)d_in[12]; const float* fb1 = (const float*)d_in[13];
    const float* fw2 = (const float*)d_in[14]; const float* fb2 = (const float*)d_in[15]; const float* fw3 = (const float*)d_in[16]; const float* ffreq = (const float*)d_in[17];
    const float* hbias = (const float*)d_in[18]; const float* w_a = (const float*)d_in[19]; const float* w_b = (const float*)d_in[20];
    const float* rcw = (const float*)d_in[21]; const float* rcb = (const float*)d_in[22]; const float* rwr = (const float*)d_in[23]; const float* rbr = (const float*)d_in[24];
    const float* rwi = (const float*)d_in[25]; const float* rbi = (const float*)d_in[26]; const float* rlam = (const float*)d_in[27];
    const float* w_c = (const float*)d_in[28]; const float* w_o = (const float*)d_in[29]; const float* w_gu = (const float*)d_in[30]; const float* w_down = (const float*)d_in[31];
    const float* final_g = (const float*)d_in[32];
    float* out = (float*)d_out;
    float* new_state = out + (size_t)2 * MCTX * D;

    char* ws = (char*)d_ws; size_t off = 0;
    auto carve = [&](size_t bytes) { char* p = ws + off; off += (bytes + 255) & ~(size_t)255; return p; };
    float* mod = (float*)carve((size_t)DEPTH * 5 * NMOD * 4);
    float* h2 = (float*)carve(1280 * 64 * 4);
    float* kraw = (float*)carve((size_t)1280 * 2048 * 4);
    float* fscale = (float*)carve(2048 * 4);
    float* x = (float*)carve((size_t)MTOK * D * 4);
    float* h = (float*)carve((size_t)MTOK * D * 4);
    float* zhy = (float*)carve((size_t)MTOK * 512 * 4);
    float* zfn = (float*)carve((size_t)MTOK * 512 * 4);
    float* zrg = (float*)carve((size_t)MTOK * D * 4);
    char* big = carve((size_t)272 * 1024 * 1024);
    bf16_t* u = (bf16_t*)big;
    char* r2 = big + (size_t)MTOK * DIN * 2;
    float* uc = (float*)r2;
    float* z1 = (float*)(r2 + (size_t)MTOK * 1536 * 4);
    float* gc = (float*)((char*)z1 + (size_t)MTOK * 512 * 4);
    float* gs = (float*)((char*)gc + (size_t)MTOK * 512 * 4);
    float* xr = (float*)((char*)gs + (size_t)MTOK * 512 * 4);
    float* ga = h;
    float* gb = (float*)((char*)xr + (size_t)MTOK * D * 4);
    bf16_t* gu = (bf16_t*)big;
    float* hm = (float*)(big + (size_t)MTOK * 2 * DFF * 2);
    if (off > ws_size) { fprintf(stderr, "ws too small: need %zu have %zu\n", off, ws_size); return; }

    (void)hipMemcpyAsync(x, x_prompt, (size_t)MCTX * D * 4, hipMemcpyDeviceToDevice, stream);
    (void)hipMemcpyAsync(x + (size_t)MCTX * D, x_sample, (size_t)MLAT * D * 4, hipMemcpyDeviceToDevice, stream);
    k_mod<<<cdiv(DEPTH * 5 * NMOD, 256), 256, 0, stream>>>(cvec, c_ctx, w_ada, b_ada, mod);

    for (int l = 0; l < DEPTH; ++l) {
        const float* modl = mod + (size_t)l * 5 * NMOD;
        k_filt_h2<<<1280, 64, 0, stream>>>(fw1 + l * 17 * 64, fb1 + l * 64, fw2 + l * 64 * 64, fb2 + l * 64, ffreq + l * 64, h2);
        k_filt_h3<<<cdiv(1280 * 2048, 256), 256, 0, stream>>>(h2, fw3 + (size_t)l * 64 * 2048, kraw);
        k_filt_norm<<<8, 256, 0, stream>>>(kraw, fscale);
        k_norm<<<MTOK / 4, 256, 0, stream>>>(x, n1g + l * D, modl, 0, D, h);
        k_gemm<EpiBf16><<<dim3(DIN / 128, MTOK / 128), 256, 0, stream>>>(h, D, w_in + (size_t)l * D * DIN, DIN, D, EpiBf16{u, DIN, 0});
        k_hy_sconv<<<cdiv((long)MTOK * 1536, 256), 256, 0, stream>>>(u, hcw + l * 3 * 1536, hcb + l * 1536, uc);
        k_hy_conv<<<cdiv((long)MTOK * 512, 256), 256, 0, stream>>>(uc, 1536, uc + 512, 1536, kraw, fscale, hbias + l * 1024, 0, z1);
        k_hy_conv<<<cdiv((long)MTOK * 512, 256), 256, 0, stream>>>(z1, 512, uc + 1024, 1536, kraw, fscale, hbias + l * 1024, 1, zhy);
        k_fnet_ch<<<cdiv((long)MTOK * 512, 256), 256, 0, stream>>>(u, gc, gs);
        k_fnet_seq<<<cdiv((long)MTOK * 512, 256), 256, 0, stream>>>(gc, gs, zfn);
        k_rg_conv<<<cdiv((long)MTOK * DRG, 256), 256, 0, stream>>>(u, rcw + l * 4 * 1024, rcb + l * 1024, xr);
        for (int dir = 0; dir < 2; ++dir) {
            k_rg_gates<<<cdiv((long)MTOK * DRG, 256), 256, 0, stream>>>(xr, rwr + (size_t)l * 2 * 8 * 128 * 128, rbr + l * 2048, rwi + (size_t)l * 2 * 8 * 128 * 128, rbi + l * 2048, rlam + l * 2048, dir, ga, gb);
            k_rg_scan<<<cdiv(20 * DRG, 256), 256, 0, stream>>>(ga, gb, state, u, l, dir, zrg, new_state);
        }
        k_gemm<EpiMerge><<<dim3(D / 128, MTOK / 128), 256, 0, stream>>>(zhy, 512, w_a + (size_t)l * 512 * D, D, 512, EpiMerge{h, u, 0, 0});
        k_gemm<EpiMerge><<<dim3(D / 128, MTOK / 128), 256, 0, stream>>>(zfn, 512, w_b + (size_t)l * 512 * D, D, 512, EpiMerge{h, u, 1, 1});
        k_gemm<EpiMerge><<<dim3(D / 128, MTOK / 128), 256, 0, stream>>>(zrg, D, w_c + (size_t)l * D * D, D, D, EpiMerge{h, u, 2, 1});
        k_gemm<EpiResid><<<dim3(D / 128, MTOK / 128), 256, 0, stream>>>(h, D, w_o + (size_t)l * D * D, D, D, EpiResid{x, modl, 2 * D, 0});
        k_norm<<<MTOK / 4, 256, 0, stream>>>(x, n2g + l * D, modl, 3 * D, 4 * D, h);
        k_gemm<EpiBf16><<<dim3(2 * DFF / 128, MTOK / 128), 256, 0, stream>>>(h, D, w_gu + (size_t)l * D * 2 * DFF, 2 * DFF, D, EpiBf16{gu, 2 * DFF, 0});
        k_swiglu<<<cdiv((long)MTOK * DFF, 256), 256, 0, stream>>>(gu, hm);
        k_gemm<EpiResid><<<dim3(D / 128, MTOK / 128), 256, 0, stream>>>(hm, DFF, w_down + (size_t)l * DFF * D, D, DFF, EpiResid{x, modl, 5 * D, 0});
    }
    k_final<<<MTOK / 4, 256, 0, stream>>>(x, final_g, out);
}
```

```cpp
#include <hip/hip_runtime.h>
#include <cstdint>
#include <cstdio>
#include <cmath>
#include <hip/hip_cooperative_groups.h>
namespace cg = cooperative_groups;

constexpr int D = 1024, DEPTH = 4;
constexpr int NCTX = 16, LCTX = 256, NLAT = 4, LLAT = 1024;
constexpr int MCTX = NCTX * LCTX, MLAT = NLAT * LLAT, MTOK = MCTX + MLAT;
constexpr int DHY = 512, DFN = 512, DRG = 1024, DFF = 2816, DIN = 7168;
constexpr int OFF_HY = 0, OFF_FN = 1536, OFF_RX = 2048, OFF_RY = 3072, OFF_G = 4096;
constexpr int NMOD = 6 * D;
constexpr float EPS = 1e-6f;
constexpr float DECAY_SLOW = 3.0701134573253945f;
constexpr float DECAY_FAST = 15.350567286626972f;

typedef short bf16x8 __attribute__((ext_vector_type(8)));
typedef float f32x4 __attribute__((ext_vector_type(4)));
typedef unsigned short bf16_t;

__device__ __forceinline__ bf16_t f2bf(float f) { unsigned u = __float_as_uint(f); return (bf16_t)((u + 0x7fffu + ((u >> 16) & 1u)) >> 16); }
__device__ __forceinline__ float bf2f(bf16_t h) { return __uint_as_float(((unsigned)h) << 16); }
__device__ __forceinline__ float sigmoidf_(float x) { return 1.f / (1.f + __expf(-x)); }
__device__ __forceinline__ float siluf_(float x) { return x / (1.f + __expf(-x)); }
__device__ __forceinline__ float gelu_tanh(float x) { const float u = 0.7978845608028654f * (x + 0.044715f * x * x * x); return 0.5f * x * (1.f + tanhf(u)); }

struct RowInfo { int grp, t, L, s0, lset, frow; };
__device__ __forceinline__ RowInfo rowinfo(int m) {
    RowInfo r;
    if (m < MCTX) { r.grp = 0; r.t = m & 255; r.L = LCTX; r.s0 = m - r.t; r.lset = 0; r.frow = 0; }
    else { const int mm = m - MCTX; r.grp = 1 + (mm >> 10); r.t = mm & 1023; r.L = LLAT; r.s0 = m - r.t; r.lset = 1; r.frow = 256; }
    return r;
}


__device__ __forceinline__ int opq_v(int v) { asm volatile("" : "+v"(v)); return v; }
__device__ __forceinline__ int opq_s(int v) { asm volatile("" : "+s"(v)); return v; }
#define PHASE_IDS const int tx = opq_v((int)threadIdx.x); const int bx = opq_s((int)blockIdx.x); const int gx = opq_s((int)gridDim.x); (void)tx; (void)bx; (void)gx;
#define GRID_LOOP(idx, N) for (long idx = (long)bx * 512 + tx; idx < (long)(N); idx += (long)gx * 512)

__device__ __forceinline__ void d_mod(const float* __restrict__ c, const float* __restrict__ c_ctx, const float* __restrict__ w_ada, const float* __restrict__ b_ada, float* __restrict__ mod) {
    PHASE_IDS
    GRID_LOOP(idx, DEPTH * 5 * NMOD) {
        const int n = idx % NMOD, g = (idx / NMOD) % 5, l = idx / (NMOD * 5);
        const float* cv = g == 0 ? c_ctx : c + (g - 1) * D;
        float acc = 0.f;
        for (int k = 0; k < D; ++k) { acc += siluf_(cv[k]) * w_ada[((size_t)l * D + k) * NMOD + n]; }
        mod[idx] = acc + b_ada[l * NMOD + n];
    }
}

__device__ __forceinline__ void d_filt_h2(float* lds, const float* __restrict__ fw1, const float* __restrict__ fb1, const float* __restrict__ fw2, const float* __restrict__ fb2, const float* __restrict__ ffreq, float* __restrict__ h2) {
    PHASE_IDS
    const int wave = tx >> 6, j = tx & 63;
    float* feats = lds + wave * 96; float* h1 = feats + 32;
    const int nw = gx * 8;
    for (int base = 0; base < 1280; base += nw) {
        const int r = base + bx * 8 + wave; const bool valid = r < 1280;
        const int L = r < 256 ? 256 : 1024; const int ti = r < 256 ? r : r - 256;
        const float t = (float)ti / (float)L;
        if (valid && j < 17) {
            float f;
            if (j == 0) f = t;
            else if (j <= 8) f = sinf(6.283185307179586f * t * (float)j);
            else f = cosf(6.283185307179586f * t * (float)(j - 8));
            feats[j] = f;
        }
        __syncthreads();
        if (valid) { float a = fb1[j]; for (int k = 0; k < 17; ++k) a += feats[k] * fw1[k * 64 + j]; h1[j] = sinf(ffreq[j] * a); }
        __syncthreads();
        if (valid) { float b = fb2[j]; for (int k = 0; k < 64; ++k) b += h1[k] * fw2[k * 64 + j]; h2[r * 64 + j] = sinf(ffreq[j] * b); }
        __syncthreads();
    }
}
__device__ __forceinline__ void d_filt_h3(const float* __restrict__ h2, const float* __restrict__ fw3, float* __restrict__ kraw) {
    PHASE_IDS
    GRID_LOOP(idx, 1280 * 2048) {
        const int j = idx & 2047, r = idx >> 11;
        const int L = r < 256 ? 256 : 1024; const int ti = r < 256 ? r : r - 256;
        const float t = (float)ti / (float)L;
        float acc = 0.f;
        for (int k = 0; k < 64; ++k) acc += h2[r * 64 + k] * fw3[k * 2048 + j];
        const int c = j & 511;
        const float delta = DECAY_SLOW + (DECAY_FAST - DECAY_SLOW) * ((float)c / 511.0f);
        kraw[idx] = acc * expf(-t * delta);
    }
}
__device__ __forceinline__ void d_filt_norm(const float* __restrict__ kraw, float* __restrict__ scale) {
    PHASE_IDS
    GRID_LOOP(idx, 2 * 2 * 512) {
        const int c = idx & 511, o = (idx >> 9) & 1, ls = idx >> 10;
        const int L = ls ? 1024 : 256, r0 = ls ? 256 : 0;
        float s = 0.f;
        for (int t = 0; t < L; ++t) { const float f = kraw[(size_t)(r0 + t) * 2048 + o * 1024 + c]; s += f * f; if (t >= 1) { const float b = kraw[(size_t)(r0 + t) * 2048 + o * 1024 + 512 + c]; s += b * b; } }
        scale[idx] = rsqrtf(s + EPS);
    }
}

__device__ __forceinline__ void d_norm(const float* __restrict__ x, const float* __restrict__ gw, const float* __restrict__ modl, int sh_off, int sc_off, float* __restrict__ h) {
    PHASE_IDS
    const int lane = tx & 63;
    for (int m = bx * 8 + (tx >> 6); m < MTOK; m += gx * 8) {
        const RowInfo ri = rowinfo(m);
        const float* xr = x + (size_t)m * D;
        float s = 0.f;
        for (int i = 0; i < 16; ++i) { const float v = xr[lane + 64 * i]; s += v * v; }
        for (int o = 1; o < 64; o <<= 1) s += __shfl_xor(s, o);
        const float rs = rsqrtf(s * (1.f / D) + EPS);
        const float* mg = modl + ri.grp * NMOD;
        for (int i = 0; i < 16; ++i) { const int k = lane + 64 * i; h[(size_t)m * D + k] = xr[k] * rs * gw[k] * (1.f + mg[sc_off + k]) + mg[sh_off + k]; }
    }
}
__device__ __forceinline__ void d_final(const float* __restrict__ x, const float* __restrict__ gw, float* __restrict__ out) {
    PHASE_IDS
    const int lane = tx & 63;
    for (int m = bx * 8 + (tx >> 6); m < MTOK; m += gx * 8) {
        const float* xr = x + (size_t)m * D;
        float s = 0.f;
        for (int i = 0; i < 16; ++i) { const float v = xr[lane + 64 * i]; s += v * v; }
        for (int o = 1; o < 64; o <<= 1) s += __shfl_xor(s, o);
        const float rs = rsqrtf(s * (1.f / D) + EPS);
        for (int i = 0; i < 16; ++i) { const int k = lane + 64 * i; out[(size_t)m * D + k] = xr[k] * rs * gw[k]; }
    }
}

template <class Epi>
__device__ __forceinline__ void d_gemm(unsigned char* lds, const float* __restrict__ A, int lda, const float* __restrict__ B, int ldb, int Mr, int N, int K, Epi epi) {
    PHASE_IDS
    const int half = tx >> 8;
    bf16_t* As = (bf16_t*)(lds + half * 20480); bf16_t* Bs = As + 128 * 40;
    const int tid = tx & 255, lane = tid & 63, w = tid >> 6, wm = w >> 1, wn = w & 1, r16 = lane & 15, quad = lane >> 4;
    const int ntn = N / 128, ntiles = (Mr / 128) * ntn;
    for (int base = bx * 2; base < ntiles; base += gx * 2) {
        const int tile = base + half; const int m0 = (tile / ntn) * 128, n0 = (tile % ntn) * 128;
        f32x4 acc[4][4];
#pragma unroll
        for (int i = 0; i < 4; ++i)
#pragma unroll
            for (int j = 0; j < 4; ++j) acc[i][j] = (f32x4){0.f, 0.f, 0.f, 0.f};
        for (int k0 = 0; k0 < K; k0 += 32) {
#pragma unroll
            for (int i = 0; i < 4; ++i) {
                const int idx = tid + i * 256, row = idx >> 3, c4 = idx & 7;
                const float4 v = *(const float4*)(A + (size_t)(m0 + row) * lda + k0 + c4 * 4);
                uint2 p; p.x = (unsigned)f2bf(v.x) | ((unsigned)f2bf(v.y) << 16); p.y = (unsigned)f2bf(v.z) | ((unsigned)f2bf(v.w) << 16);
                *(uint2*)&As[row * 40 + c4 * 4] = p;
            }
#pragma unroll
            for (int i = 0; i < 4; ++i) {
                const int idx = tid + i * 256, kk = idx >> 5, n4 = idx & 31;
                const float4 v = *(const float4*)(B + (size_t)(k0 + kk) * ldb + n0 + n4 * 4);
                Bs[(n4 * 4 + 0) * 40 + kk] = f2bf(v.x); Bs[(n4 * 4 + 1) * 40 + kk] = f2bf(v.y);
                Bs[(n4 * 4 + 2) * 40 + kk] = f2bf(v.z); Bs[(n4 * 4 + 3) * 40 + kk] = f2bf(v.w);
            }
            __syncthreads();
            bf16x8 a[4], b[4];
#pragma unroll
            for (int mt = 0; mt < 4; ++mt) a[mt] = *(const bf16x8*)&As[(wm * 64 + mt * 16 + r16) * 40 + quad * 8];
#pragma unroll
            for (int nt = 0; nt < 4; ++nt) b[nt] = *(const bf16x8*)&Bs[(wn * 64 + nt * 16 + r16) * 40 + quad * 8];
#pragma unroll
            for (int mt = 0; mt < 4; ++mt)
#pragma unroll
                for (int nt = 0; nt < 4; ++nt) acc[mt][nt] = __builtin_amdgcn_mfma_f32_16x16x32_bf16(a[mt], b[nt], acc[mt][nt], 0, 0, 0);
            __syncthreads();
        }
#pragma unroll
        for (int mt = 0; mt < 4; ++mt)
#pragma unroll
            for (int nt = 0; nt < 4; ++nt)
#pragma unroll
                for (int j = 0; j < 4; ++j) epi(m0 + wm * 64 + mt * 16 + quad * 4 + j, n0 + wn * 64 + nt * 16 + r16, acc[mt][nt][j]);
    }
}
struct EpiBf16 { bf16_t* out; int ld; __device__ void operator()(int r, int c, float v) const { out[(size_t)r * ld + c] = f2bf(v); } };
struct EpiMerge { float* merged; const bf16_t* u; int which; int accum;
    __device__ void operator()(int r, int c, float v) const { const float g = sigmoidf_(bf2f(u[(size_t)r * DIN + OFF_G + which * D + c])); const float val = g * v; float* p = merged + (size_t)r * D + c; if (accum) *p += val; else *p = val; } };
struct EpiResid { float* x; const float* modl; int goff;
    __device__ void operator()(int r, int c, float v) const { const int grp = r < MCTX ? 0 : 1 + ((r - MCTX) >> 10); x[(size_t)r * D + c] += modl[grp * NMOD + goff + c] * v; } };

__device__ __forceinline__ void d_hy_sconv(const bf16_t* __restrict__ u, const float* __restrict__ cw, const float* __restrict__ cb, float* __restrict__ uc) {
    PHASE_IDS
    GRID_LOOP(idx, (long)MTOK * 1536) {
        const int j = idx % 1536, m = idx / 1536; const RowInfo ri = rowinfo(m);
        float a = cb[j];
        for (int k = 0; k < 3; ++k) { const int tt = ri.t + k - 1; if (tt >= 0 && tt < ri.L) a += bf2f(u[(size_t)(m + k - 1) * DIN + OFF_HY + j]) * cw[k * 1536 + j]; }
        uc[idx] = a;
    }
}
__device__ __forceinline__ void d_hy_conv(const float* __restrict__ zin, int ldz, const float* __restrict__ gate, int ldg, const float* __restrict__ kraw, const float* __restrict__ scale, const float* __restrict__ hbias, int o, float* __restrict__ out) {
    PHASE_IDS
    GRID_LOOP(idx, (long)MTOK * 512) {
        const int c = idx & 511, m = idx >> 9; const RowInfo ri = rowinfo(m);
        float acc = 0.f;
        for (int s = 0; s < ri.L; ++s) {
            const int d = ri.t - s; const int ad = d < 0 ? -d : d; const int dir = d < 0 ? 1 : 0;
            acc += kraw[(size_t)(ri.frow + ad) * 2048 + o * 1024 + dir * 512 + c] * zin[(size_t)(ri.s0 + s) * ldz + c];
        }
        acc *= scale[(ri.lset * 2 + o) * 512 + c];
        out[idx] = gate[(size_t)m * ldg + c] * (acc + hbias[o * 512 + c] * zin[(size_t)m * ldz + c]);
    }
}

__device__ __forceinline__ void d_fnet_ch(const bf16_t* __restrict__ u, float* __restrict__ gc, float* __restrict__ gs) {
    PHASE_IDS
    GRID_LOOP(idx, (long)MTOK * 512) {
        const int j = idx & 511, m = idx >> 9, g = j >> 7, c = j & 127;
        float ac = 0.f, as = 0.f;
        for (int cc = 0; cc < 128; ++cc) {
            float sn, cs; sincospif((float)((c * cc) & 127) * (2.0f / 128.0f), &sn, &cs);
            const float v = bf2f(u[(size_t)m * DIN + OFF_FN + g * 128 + cc]);
            ac += v * cs; as += v * sn;
        }
        gc[idx] = ac; gs[idx] = as;
    }
}
__device__ __forceinline__ void d_fnet_seq(const float* __restrict__ gc, const float* __restrict__ gs, float* __restrict__ out) {
    PHASE_IDS
    GRID_LOOP(idx, (long)MTOK * 512) {
        const int j = idx & 511, m = idx >> 9; const RowInfo ri = rowinfo(m);
        float acc = 0.f;
        for (int l = 0; l < ri.L; ++l) {
            float sn, cs; sincospif((float)((l * ri.t) & (ri.L - 1)) * (2.0f / (float)ri.L), &sn, &cs);
            acc += cs * gc[(size_t)(ri.s0 + l) * 512 + j] - sn * gs[(size_t)(ri.s0 + l) * 512 + j];
        }
        out[idx] = acc * rsqrtf((float)ri.L * 128.0f);
    }
}

__device__ __forceinline__ void d_rg_conv(const bf16_t* __restrict__ u, const float* __restrict__ cw, const float* __restrict__ cb, float* __restrict__ xr) {
    PHASE_IDS
    GRID_LOOP(idx, (long)MTOK * DRG) {
        const int ch = idx & 1023, m = idx >> 10; const RowInfo ri = rowinfo(m);
        float a = cb[ch];
        for (int k = 0; k < 4; ++k) { const int tt = ri.t + k - 2; if (tt >= 0 && tt < ri.L) a += bf2f(u[(size_t)(m + k - 2) * DIN + OFF_RX + ch]) * cw[k * 1024 + ch]; }
        xr[idx] = a;
    }
}
__device__ __forceinline__ void d_rg_gates(const float* __restrict__ xr, const float* __restrict__ wr, const float* __restrict__ br, const float* __restrict__ wi, const float* __restrict__ bi, const float* __restrict__ lam, int dir, float* __restrict__ ga, float* __restrict__ gb) {
    PHASE_IDS
    GRID_LOOP(idx, (long)MTOK * DRG) {
        const int ch = idx & 1023, m = idx >> 10, n = ch >> 7, d = ch & 127; const RowInfo ri = rowinfo(m);
        const float* wrp = wr + ((size_t)(dir * 8 + n) * 128) * 128 + d;
        const float* wip = wi + ((size_t)(dir * 8 + n) * 128) * 128 + d;
        const float* xp = xr + (size_t)m * DRG + n * 128;
        float r = br[dir * 1024 + ch], i = bi[dir * 1024 + ch];
        for (int c = 0; c < 128; ++c) { const float xv = xp[c]; r += xv * wrp[c * 128]; i += xv * wip[c * 128]; }
        r = sigmoidf_(r); i = sigmoidf_(i);
        const float lm = lam[dir * 1024 + ch];
        const float sp = log1pf(expf(-lm));
        const float log_a = -8.0f * r * sp;
        const float a = expf(log_a);
        float mult = sqrtf(-expm1f(2.0f * log_a));
        if (ri.grp == 0 && ((dir == 0 && ri.t == 0) || (dir == 1 && ri.t == ri.L - 1))) mult = 1.0f;
        ga[idx] = a; gb[idx] = mult * i * xr[idx];
    }
}
__device__ __forceinline__ void d_rg_scan(const float* __restrict__ ga, const float* __restrict__ gb, const float* __restrict__ state, const bf16_t* __restrict__ u, int layer, int dir, float* __restrict__ zrg, float* __restrict__ new_state) {
    PHASE_IDS
    GRID_LOOP(idx, 20 * DRG) {
        const int ch = idx & 1023, seq = idx >> 10;
        int s0, L; float h;
        if (seq < NCTX) { s0 = seq * LCTX; L = LCTX; h = 0.f; }
        else { const int b = seq - NCTX; s0 = MCTX + b * LLAT; L = LLAT; h = state[((size_t)(b * DEPTH + layer) * 2 + dir) * DRG + ch]; }
        if (dir == 0) {
            for (int t = 0; t < L; ++t) { const size_t o = (size_t)(s0 + t) * DRG + ch; h = ga[o] * h + gb[o]; zrg[o] = h; }
        } else {
            for (int t = L - 1; t >= 0; --t) { const size_t o = (size_t)(s0 + t) * DRG + ch; h = ga[o] * h + gb[o];
                zrg[o] = (zrg[o] + h) * gelu_tanh(bf2f(u[(size_t)(s0 + t) * DIN + OFF_RY + ch])); }
        }
        if (seq < NCTX) new_state[((size_t)(seq * DEPTH + layer) * 2 + dir) * DRG + ch] = h;
    }
}
__device__ __forceinline__ void d_swiglu(const bf16_t* __restrict__ gu, float* __restrict__ hm) {
    PHASE_IDS
    GRID_LOOP(idx, (long)MTOK * DFF) {
        const int j = idx % DFF, m = idx / DFF;
        hm[idx] = siluf_(bf2f(gu[(size_t)m * 2 * DFF + j])) * bf2f(gu[(size_t)m * 2 * DFF + DFF + j]);
    }
}

struct Params { const float* in[33]; float* out; unsigned char* ws; };
constexpr int LDS_BYTES = 147456;
constexpr size_t MiB = (size_t)1 << 20;
constexpr size_t WS_MOD = 0, WS_H2 = 1 * MiB, WS_FSC = 2 * MiB - 65536, WS_KRAW = 2 * MiB, WS_X = 13 * MiB, WS_H = 45 * MiB, WS_ZHY = 77 * MiB, WS_ZFN = 93 * MiB, WS_ZRG = 109 * MiB,
                 WS_BIG = 141 * MiB, WS_END = WS_BIG + 272 * MiB;

__global__ void __launch_bounds__(512, 2) mega(Params p) {
    cg::grid_group grid = cg::this_grid();
    extern __shared__ __attribute__((aligned(16))) unsigned char lds[];
    const float* x_prompt = p.in[0]; const float* x_sample = p.in[1]; const float* cvec = p.in[2];
    const float* state = p.in[3]; const float* c_ctx = p.in[4]; const float* n1g = p.in[5]; const float* n2g = p.in[6];
    const float* w_ada = p.in[7]; const float* b_ada = p.in[8]; const float* w_in = p.in[9];
    const float* hcw = p.in[10]; const float* hcb = p.in[11]; const float* fw1 = p.in[12]; const float* fb1 = p.in[13];
    const float* fw2 = p.in[14]; const float* fb2 = p.in[15]; const float* fw3 = p.in[16]; const float* ffreq = p.in[17];
    const float* hbias = p.in[18]; const float* w_a = p.in[19]; const float* w_b = p.in[20];
    const float* rcw = p.in[21]; const float* rcb = p.in[22]; const float* rwr = p.in[23]; const float* rbr = p.in[24];
    const float* rwi = p.in[25]; const float* rbi = p.in[26]; const float* rlam = p.in[27];
    const float* w_c = p.in[28]; const float* w_o = p.in[29]; const float* w_gu = p.in[30]; const float* w_down = p.in[31];
    const float* final_g = p.in[32];
    float* out = p.out; float* new_state = out + (size_t)2 * MCTX * D;
    unsigned char* ws = p.ws;
    float* mod = (float*)(ws + WS_MOD); float* h2 = (float*)(ws + WS_H2); float* fscale = (float*)(ws + WS_FSC); float* kraw = (float*)(ws + WS_KRAW);
    float* x = (float*)(ws + WS_X); float* h = (float*)(ws + WS_H); float* zhy = (float*)(ws + WS_ZHY); float* zfn = (float*)(ws + WS_ZFN); float* zrg = (float*)(ws + WS_ZRG);
    unsigned char* big = ws + WS_BIG;
    bf16_t* u = (bf16_t*)big;
    unsigned char* r2 = big + (size_t)MTOK * DIN * 2;
    float* uc = (float*)r2; float* z1 = (float*)(r2 + 48 * MiB); float* gc = (float*)(r2 + 64 * MiB); float* gs = (float*)(r2 + 80 * MiB);
    float* xr = (float*)(r2 + 96 * MiB); float* gb = (float*)(r2 + 128 * MiB); float* ga = h;
    bf16_t* gu = (bf16_t*)big; float* hm = (float*)(big + (size_t)MTOK * 2 * DFF * 2);

    { PHASE_IDS
    GRID_LOOP(i, (long)MCTX * D / 4) ((float4*)x)[i] = ((const float4*)x_prompt)[i];
    GRID_LOOP(i, (long)MLAT * D / 4) ((float4*)(x + (size_t)MCTX * D))[i] = ((const float4*)x_sample)[i]; }
    d_mod(cvec, c_ctx, w_ada, b_ada, mod);
    grid.sync();
    for (int l = 0; l < DEPTH; ++l) {
        const float* modl = mod + (size_t)l * 5 * NMOD;
        d_filt_h2((float*)lds, fw1 + l * 17 * 64, fb1 + l * 64, fw2 + l * 64 * 64, fb2 + l * 64, ffreq + l * 64, h2);
        d_norm(x, n1g + l * D, modl, 0, D, h);
        grid.sync();
        d_filt_h3(h2, fw3 + (size_t)l * 64 * 2048, kraw);
        d_gemm(lds, h, D, w_in + (size_t)l * D * DIN, DIN, MTOK, DIN, D, EpiBf16{u, DIN});
        grid.sync();
        d_filt_norm(kraw, fscale);
        d_hy_sconv(u, hcw + l * 3 * 1536, hcb + l * 1536, uc);
        d_fnet_ch(u, gc, gs);
        d_rg_conv(u, rcw + l * 4 * 1024, rcb + l * 1024, xr);
        grid.sync();
        d_hy_conv(uc, 1536, uc + 512, 1536, kraw, fscale, hbias + l * 1024, 0, z1);
        d_fnet_seq(gc, gs, zfn);
        d_rg_gates(xr, rwr + (size_t)l * 2 * 8 * 128 * 128, rbr + l * 2048, rwi + (size_t)l * 2 * 8 * 128 * 128, rbi + l * 2048, rlam + l * 2048, 0, ga, gb);
        grid.sync();
        d_hy_conv(z1, 512, uc + 1024, 1536, kraw, fscale, hbias + l * 1024, 1, zhy);
        d_rg_scan(ga, gb, state, u, l, 0, zrg, new_state);
        grid.sync();
        d_rg_gates(xr, rwr + (size_t)l * 2 * 8 * 128 * 128, rbr + l * 2048, rwi + (size_t)l * 2 * 8 * 128 * 128, rbi + l * 2048, rlam + l * 2048, 1, ga, gb);
        grid.sync();
        d_rg_scan(ga, gb, state, u, l, 1, zrg, new_state);
        grid.sync();
        d_gemm(lds, zhy, 512, w_a + (size_t)l * 512 * D, D, MTOK, D, 512, EpiMerge{h, u, 0, 0});
        d_gemm(lds, zfn, 512, w_b + (size_t)l * 512 * D, D, MTOK, D, 512, EpiMerge{h, u, 1, 1});
        d_gemm(lds, zrg, D, w_c + (size_t)l * D * D, D, MTOK, D, D, EpiMerge{h, u, 2, 1});
        grid.sync();
        d_gemm(lds, h, D, w_o + (size_t)l * D * D, D, MTOK, D, D, EpiResid{x, modl, 2 * D});
        grid.sync();
        d_norm(x, n2g + l * D, modl, 3 * D, 4 * D, h);
        grid.sync();
        d_gemm(lds, h, D, w_gu + (size_t)l * D * 2 * DFF, 2 * DFF, MTOK, 2 * DFF, D, EpiBf16{gu, 2 * DFF});
        grid.sync();
        d_swiglu(gu, hm);
        grid.sync();
        d_gemm(lds, hm, DFF, w_down + (size_t)l * DFF * D, D, MTOK, D, DFF, EpiResid{x, modl, 5 * D});
        grid.sync();
    }
    d_final(x, final_g, out);
}

extern "C" void kernel_launch(void* const* d_in, const int* in_sizes, int n_in, void* d_out, int out_size, void* d_ws, size_t ws_size, hipStream_t stream) {
    static int grid_blocks = 0;
    if (grid_blocks == 0) {
        if (n_in != 33 || ws_size < WS_END) { fprintf(stderr, "kernel_launch: unexpected n_in %d or ws_size %zu (need %zu)\n", n_in, ws_size, (size_t)WS_END); grid_blocks = -1; return; }
        int dev = 0, cus = 0, per_cu = 0;
        (void)hipGetDevice(&dev);
        (void)hipDeviceGetAttribute(&cus, hipDeviceAttributeMultiprocessorCount, dev);
        (void)hipFuncSetAttribute((const void*)mega, hipFuncAttributeMaxDynamicSharedMemorySize, LDS_BYTES);
        (void)hipOccupancyMaxActiveBlocksPerMultiprocessor(&per_cu, (const void*)mega, 512, LDS_BYTES);
        if (per_cu < 1 || cus < 1) { fprintf(stderr, "kernel_launch: occupancy query gave %d blocks/CU on %d CUs\n", per_cu, cus); grid_blocks = -1; return; }
        grid_blocks = cus * per_cu;
    }
    if (grid_blocks < 0) return;
    Params p{};
    for (int i = 0; i < 33; ++i) p.in[i] = (const float*)d_in[i];
    p.out = (float*)d_out; p.ws = (unsigned char*)d_ws;
    void* args[] = {&p};
    hipError_t e = hipLaunchCooperativeKernel((const void*)mega, dim3(grid_blocks), dim3(512), args, LDS_BYTES, stream);
    if (e != hipSuccess) fprintf(stderr, "cooperative launch failed: %s (grid %d)\n", hipGetErrorString(e), grid_blocks);
}
```

```cpp
#include <hip/hip_runtime.h>
#include <cstdint>
#include <cstdio>
#include <cmath>
#include <hip/hip_cooperative_groups.h>
namespace cg = cooperative_groups;

constexpr int D = 1024, DEPTH = 4;
constexpr int NCTX = 16, LCTX = 256, NLAT = 4, LLAT = 1024;
constexpr int MCTX = NCTX * LCTX, MLAT = NLAT * LLAT, MTOK = MCTX + MLAT;
constexpr int DHY = 512, DFN = 512, DRG = 1024, DFF = 2816, DIN = 7168;
constexpr int OFF_HY = 0, OFF_FN = 1536, OFF_RX = 2048, OFF_RY = 3072, OFF_G = 4096;
constexpr int NMOD = 6 * D;
constexpr float EPS = 1e-6f;
constexpr float DECAY_SLOW = 3.0701134573253945f;
constexpr float DECAY_FAST = 15.350567286626972f;

typedef short bf16x8 __attribute__((ext_vector_type(8)));
typedef float f32x4 __attribute__((ext_vector_type(4)));
typedef unsigned short bf16_t;

__device__ __forceinline__ bf16_t f2bf(float f) { unsigned u = __float_as_uint(f); return (bf16_t)((u + 0x7fffu + ((u >> 16) & 1u)) >> 16); }
__device__ __forceinline__ float bf2f(bf16_t h) { return __uint_as_float(((unsigned)h) << 16); }
__device__ __forceinline__ float sigmoidf_(float x) { return 1.f / (1.f + __expf(-x)); }
__device__ __forceinline__ float siluf_(float x) { return x / (1.f + __expf(-x)); }
__device__ __forceinline__ float gelu_tanh(float x) { const float u = 0.7978845608028654f * (x + 0.044715f * x * x * x); return 0.5f * x * (1.f + tanhf(u)); }

struct RowInfo { int grp, t, L, s0, lset, frow; };
__device__ __forceinline__ RowInfo rowinfo(int m) {
    RowInfo r;
    if (m < MCTX) { r.grp = 0; r.t = m & 255; r.L = LCTX; r.s0 = m - r.t; r.lset = 0; r.frow = 0; }
    else { const int mm = m - MCTX; r.grp = 1 + (mm >> 10); r.t = mm & 1023; r.L = LLAT; r.s0 = m - r.t; r.lset = 1; r.frow = 256; }
    return r;
}


__device__ __forceinline__ int opq_v(int v) { asm volatile("" : "+v"(v)); return v; }
__device__ __forceinline__ int opq_s(int v) { asm volatile("" : "+s"(v)); return v; }
namespace pg8 {
#define PG8_LAS __attribute__((address_space(3)))
typedef unsigned short bf16_t;
typedef short bf16x8 __attribute__((ext_vector_type(8)));
typedef float f32x4 __attribute__((ext_vector_type(4)));
typedef unsigned u32x4 __attribute__((ext_vector_type(4)));
constexpr int BM = 256, BK = 64, HALF = 128, HTB = HALF * BK * 2  , STAGE_BYTES = 8 * HTB, NXCD = 8, WGM = 8;

__host__ __device__ __forceinline__ int lds_byte(int r, int c) { const int st = (r >> 4) * 2 + (c >> 5), rr = r & 15, cc = c & 31, ob = rr * 64 + cc * 2; return st * 1024 + (ob ^ (((ob >> 9) & 1) << 5)); }
__host__ __device__ __forceinline__ void stage_rc(int b, int& R, int& C) { const int st = b / 1024, sb = b % 1024, swz = sb ^ (((sb >> 9) & 1) << 5); R = (st >> 1) * 16 + swz / 64; C = (st & 1) * 32 + (swz % 64) / 2; }
__host__ __device__ __forceinline__ int perm32(int rho) { const int n = rho >> 4, i = rho & 15; return 8 * (i >> 2) + 4 * n + (i & 3); }

struct Unit { int pm, pn; };
struct Gemm { const bf16_t* A; const bf16_t* Bt; int M, N, K; };

struct StaticOrder {
    int nM, nN, nwg, G, c;
    __host__ __device__ void init(int M, int N, int G_, int c_) { nM = M / BM; nN = N / BM; nwg = nM * nN; G = G_; c = c_; }
    __host__ __device__ bool next(int i, Unit& u) const {
        const long L = (long)i * G + c; if (L >= nwg) return false;
        int wgid = (int)L; { const int q = nwg / NXCD, r = nwg % NXCD, xcd = wgid % NXCD, off = wgid / NXCD; wgid = (xcd < r ? xcd * (q + 1) : r * (q + 1) + (xcd - r) * q) + off; }
        const int nig = WGM * nN, gid = wgid / nig, fm = gid * WGM, gsz = (nM - fm) < WGM ? (nM - fm) : WGM;
        u.pm = fm + ((wgid % nig) % gsz); u.pn = (wgid % nig) / gsz; return true;
    }
    __device__ __forceinline__ void a_ready(const Unit&) const {}
    __device__ __forceinline__ void done(const Unit&) const {}
};

__device__ __forceinline__ unsigned cvt_pk_bf16(float lo, float hi) { unsigned r; asm volatile("v_cvt_pk_bf16_f32 %0, %1, %2" : "=v"(r) : "v"(lo), "v"(hi)); return r; }
typedef float f32x2 __attribute__((ext_vector_type(2)));
__device__ __forceinline__ f32x2 gelu_pk(f32x2 v) {
    const f32x2 av = __builtin_elementwise_abs(v), d = av * 0.2316418882f + 1.0f;
    f32x2 t; t.x = __builtin_amdgcn_rcpf(d.x); t.y = __builtin_amdgcn_rcpf(d.y);
    f32x2 q = t * 0.5307027145f + (-0.7265760135f); q = q * t + 0.7107068705f; q = q * t + (-0.142248368f); q = q * t + 0.127414796f; q = q * t;
    const f32x2 s = (v * v) * (-0.72134752044f);
    f32x2 e; e.x = __builtin_amdgcn_exp2f(s.x); e.y = __builtin_amdgcn_exp2f(s.y);
    const f32x2 m = v * (q * e), r = v - m;
    f32x2 o; o.x = v.x < 0.f ? m.x : r.x; o.y = v.y < 0.f ? m.y : r.y; return o;
}

template <int ACT  > struct EpiBf16 {
    static constexpr bool PERM = true, AFTER_DRAIN = false; static_assert(ACT == 0 || ACT == 1, "EpiBf16: ACT is 0 (none) or 1 (gelu_pk)");
    bf16_t* O; int ldc; const float* bias; int split_cols; size_t split_stride; float scale0;
    __device__ __forceinline__ void operator()(const f32x4 (&acc)[2][2][4][2], const Unit& u, int wr, int wc, int fr, int fq) const {
        const int row0 = u.pm * BM + wr * 64 + fr; int colt = u.pn * BM; bf16_t* base = O;
        float sc = 1.f; if (split_cols) { const int t = colt / split_cols; base += (size_t)t * split_stride; colt -= t * split_cols; if (t == 0) sc = scale0; }
        const int col0 = colt + wc * 32 + 8 * fq, bcol0 = u.pn * BM + wc * 32 + 8 * fq;
        f32x4 bv[2][2];
#pragma unroll
        for (int bj = 0; bj < 2; ++bj)
#pragma unroll
            for (int n = 0; n < 2; ++n) bv[bj][n] = bias ? *(const f32x4*)(bias + bcol0 + bj * HALF + 4 * n) : (f32x4){0.f, 0.f, 0.f, 0.f};
#pragma unroll
        for (int ai = 0; ai < 2; ++ai)
#pragma unroll
            for (int m = 0; m < 4; ++m) { bf16_t* rowp = base + (size_t)(row0 + ai * HALF + m * 16) * ldc + col0;
#pragma unroll
                for (int bj = 0; bj < 2; ++bj) { f32x4 v0 = acc[ai][bj][m][0] + bv[bj][0], v1 = acc[ai][bj][m][1] + bv[bj][1];
                    if (ACT == 1) { f32x2 a = gelu_pk((f32x2){v0[0], v0[1]}), b = gelu_pk((f32x2){v0[2], v0[3]}), c = gelu_pk((f32x2){v1[0], v1[1]}), d = gelu_pk((f32x2){v1[2], v1[3]});
                        v0 = (f32x4){a.x, a.y, b.x, b.y}; v1 = (f32x4){c.x, c.y, d.x, d.y}; }
                    v0 = v0 * sc; v1 = v1 * sc; u32x4 w; w.x = cvt_pk_bf16(v0[0], v0[1]); w.y = cvt_pk_bf16(v0[2], v0[3]); w.z = cvt_pk_bf16(v1[0], v1[1]); w.w = cvt_pk_bf16(v1[2], v1[3]);
                    *(u32x4*)(rowp + bj * HALF) = w; } }
    }
};

template <class Epi, class Sched, bool ALIGN_EPI = false, bool SP2 = false>
__device__ __forceinline__ void gemm_phase(PG8_LAS unsigned char* lds, const Gemm g, const Sched& S, const Epi& E) {
    const int tid = opq_v((int)threadIdx.x), wid = __builtin_amdgcn_readfirstlane(tid >> 6), lane = tid & 63, wr = wid >> 2, wc = wid & 3, fr = lane & 15, fq = lane >> 4;
    const int K = g.K, nt = K / BK;
    unsigned voffA[2], voffB[2];
#pragma unroll
    for (int i = 0; i < 2; ++i) { int R, C; stage_rc(tid * 16 + i * 8192, R, C); const int Rb = Epi::PERM ? ((R & ~31) + perm32(R & 31)) : R;
        voffA[i] = (unsigned)(R * K + C) * 2u; voffB[i] = (unsigned)(Rb * K + C) * 2u; }
    const size_t kstep = (size_t)(BK * 2);
    const size_t hstep = (size_t)HALF * K * 2;
    const size_t tstep = 2 * hstep;
    const unsigned ldsw = (unsigned)wid * 1024u;
    const int aoff = lds_byte(wr * 64 + fr, fq * 8), boff = lds_byte(wc * 32 + fr, fq * 8);
#define PG8_SA(b, h) (((b) * 2 + (h)) * HTB)
#define PG8_SB(b, h) ((4 + (b) * 2 + (h)) * HTB)
#define PG8_STAGE(bufoff, gbase, voff) do { _Pragma("unroll") for (int _i = 0; _i < 2; ++_i) \
        __builtin_amdgcn_global_load_lds((const unsigned*)((const char*)(gbase) + (voff)[_i]), (PG8_LAS unsigned*)(lds + (bufoff) + ldsw + _i * 8192), 16, 0, 0); } while (0)
#define PG8_LDA(dst, b, h) do { _Pragma("unroll") for (int m = 0; m < 4; ++m) _Pragma("unroll") for (int k = 0; k < 2; ++k) dst[m][k] = *(const PG8_LAS bf16x8*)(lds + PG8_SA(b, h) + aoff + m * 2048 + k * 1024); } while (0)
#define PG8_LDB(dst, b, h) do { _Pragma("unroll") for (int n = 0; n < 2; ++n) _Pragma("unroll") for (int k = 0; k < 2; ++k) dst[n][k] = *(const PG8_LAS bf16x8*)(lds + PG8_SB(b, h) + boff + n * 2048 + k * 1024); } while (0)
#define PG8_MMA(ai, bj, At, Bt) do { __builtin_amdgcn_s_setprio(1); _Pragma("unroll") for (int m = 0; m < 4; ++m) _Pragma("unroll") for (int n = 0; n < 2; ++n) _Pragma("unroll") for (int k = 0; k < 2; ++k) \
        acc[ai][bj][m][n] = __builtin_amdgcn_mfma_f32_16x16x32_bf16(Bt[n][k], At[m][k], acc[ai][bj][m][n], 0, 0, 0); __builtin_amdgcn_s_setprio(0); } while (0)
#define PG8_WAIT_V(n) asm volatile("s_waitcnt vmcnt(" #n ")" ::: "memory")
#define PG8_WAIT_L(n) asm volatile("s_waitcnt lgkmcnt(" #n ")" ::: "memory")
#define PG8_BAR __builtin_amdgcn_s_barrier()
#define PG8_SCHED __builtin_amdgcn_sched_barrier(0)
    Unit cur, nxt; int ui = 0;
    if (!S.next(0, cur)) return;
    f32x4 acc[2][2][4][2];
#pragma unroll
    for (int a = 0; a < 2; ++a)
#pragma unroll
        for (int b = 0; b < 2; ++b)
#pragma unroll
            for (int m = 0; m < 4; ++m)
#pragma unroll
                for (int n = 0; n < 2; ++n) acc[a][b][m][n] = (f32x4){0.f, 0.f, 0.f, 0.f};
    bf16x8 At[4][2], B0[2][2], B1[2][2];
    const char* cA = (const char*)g.A + (size_t)cur.pm * tstep; const char* cB = (const char*)g.Bt + (size_t)cur.pn * tstep;
    S.a_ready(cur);
    if constexpr (SP2) {
        PG8_STAGE(PG8_SB(0, 0), cB, voffB); PG8_STAGE(PG8_SB(0, 1), cB + hstep, voffB); PG8_STAGE(PG8_SA(0, 0), cA, voffA); PG8_STAGE(PG8_SA(0, 1), cA + hstep, voffA);
        if (wr == 1) PG8_BAR;
        PG8_WAIT_V(2); PG8_BAR;
        PG8_STAGE(PG8_SB(1, 0), cB + kstep, voffB); PG8_STAGE(PG8_SA(1, 0), cA + kstep, voffA); PG8_STAGE(PG8_SB(1, 1), cB + hstep + kstep, voffB);
        PG8_WAIT_V(6); PG8_BAR;
    } else {
        PG8_STAGE(PG8_SB(0, 0), cB, voffB); PG8_STAGE(PG8_SA(0, 0), cA, voffA); PG8_STAGE(PG8_SB(0, 1), cB + hstep, voffB); PG8_STAGE(PG8_SA(0, 1), cA + hstep, voffA);
        if (wr == 1) PG8_BAR;
        PG8_WAIT_V(4); PG8_BAR;
        PG8_STAGE(PG8_SB(1, 0), cB + kstep, voffB); PG8_STAGE(PG8_SA(1, 0), cA + kstep, voffA); PG8_STAGE(PG8_SB(1, 1), cB + hstep + kstep, voffB);
        PG8_WAIT_V(6); PG8_BAR;
    }
    for (;;) {
        const bool has_next = S.next(ui + 1, nxt);
        const char* nA = has_next ? (const char*)g.A + (size_t)nxt.pm * tstep : cA; const char* nB = has_next ? (const char*)g.Bt + (size_t)nxt.pn * tstep : cB;
        for (int t = 0; t < nt; t += 2) {
            const bool last = (t == nt - 2);
            const char* a1 = cA + (size_t)(t + 1) * kstep;
            const char* a2 = last ? nA : cA + (size_t)(t + 2) * kstep; const char* b2 = last ? nB : cB + (size_t)(t + 2) * kstep;
            const char* a3 = a2 + kstep; const char* b3 = b2 + kstep;
            if (last && has_next) S.a_ready(nxt);
            if constexpr (SP2) {
            PG8_LDB(B0, 0, 0); PG8_LDB(B1, 0, 1); PG8_SCHED; PG8_LDA(At, 0, 0); PG8_STAGE(PG8_SA(1, 1), a1 + hstep, voffA);
            PG8_WAIT_V(8); PG8_WAIT_L(0); PG8_BAR; PG8_MMA(0, 0, At, B0); PG8_MMA(0, 1, At, B1); PG8_BAR; PG8_SCHED;
            PG8_LDA(At, 0, 1); PG8_STAGE(PG8_SB(0, 0), b2, voffB); PG8_STAGE(PG8_SB(0, 1), b2 + hstep, voffB); PG8_STAGE(PG8_SA(0, 0), a2, voffA);
            PG8_WAIT_V(8); PG8_WAIT_L(0); PG8_BAR; PG8_MMA(1, 0, At, B0); PG8_MMA(1, 1, At, B1); PG8_BAR; PG8_SCHED;
            PG8_LDB(B0, 1, 0); PG8_LDB(B1, 1, 1); PG8_SCHED; PG8_LDA(At, 1, 0); PG8_STAGE(PG8_SA(0, 1), a2 + hstep, voffA);
            PG8_WAIT_V(8); PG8_WAIT_L(0); PG8_BAR; PG8_MMA(0, 0, At, B0); PG8_MMA(0, 1, At, B1); PG8_BAR; PG8_SCHED;
            PG8_LDA(At, 1, 1); PG8_STAGE(PG8_SB(1, 0), b3, voffB); PG8_STAGE(PG8_SB(1, 1), b3 + hstep, voffB); PG8_STAGE(PG8_SA(1, 0), a3, voffA);
            PG8_WAIT_V(8); PG8_WAIT_L(0); PG8_BAR; PG8_MMA(1, 0, At, B0); PG8_MMA(1, 1, At, B1); PG8_BAR; PG8_SCHED;
            } else {
            PG8_LDB(B0, 0, 0); PG8_SCHED; PG8_LDA(At, 0, 0); PG8_STAGE(PG8_SA(1, 1), a1 + hstep, voffA);
            PG8_WAIT_L(8); PG8_BAR; PG8_WAIT_L(0); PG8_MMA(0, 0, At, B0); PG8_BAR; PG8_SCHED;
            PG8_LDB(B1, 0, 1); PG8_STAGE(PG8_SB(0, 0), b2, voffB);
            PG8_BAR; PG8_WAIT_L(0); PG8_MMA(0, 1, At, B1); PG8_BAR;
            PG8_LDA(At, 0, 1); PG8_STAGE(PG8_SA(0, 0), a2, voffA);
            PG8_BAR; PG8_WAIT_L(0); PG8_MMA(1, 0, At, B0); PG8_BAR; PG8_SCHED;
            PG8_STAGE(PG8_SB(0, 1), b2 + hstep, voffB);
            PG8_WAIT_V(6); PG8_BAR; PG8_MMA(1, 1, At, B1); PG8_BAR;
            PG8_LDB(B0, 1, 0); PG8_SCHED; PG8_LDA(At, 1, 0); PG8_STAGE(PG8_SA(0, 1), a2 + hstep, voffA);
            PG8_WAIT_L(8); PG8_BAR; PG8_WAIT_L(0); PG8_MMA(0, 0, At, B0); PG8_BAR; PG8_SCHED;
            PG8_LDB(B1, 1, 1); PG8_STAGE(PG8_SB(1, 0), b3, voffB);
            PG8_BAR; PG8_WAIT_L(0); PG8_MMA(0, 1, At, B1); PG8_BAR;
            PG8_LDA(At, 1, 1); PG8_STAGE(PG8_SA(1, 0), a3, voffA);
            PG8_BAR; PG8_WAIT_L(0); PG8_MMA(1, 0, At, B0); PG8_BAR; PG8_SCHED;
            PG8_STAGE(PG8_SB(1, 1), b3 + hstep, voffB);
            PG8_WAIT_V(6); PG8_BAR; PG8_MMA(1, 1, At, B1); PG8_BAR;
            }
        }
        if constexpr (ALIGN_EPI) { if (wr == 0) PG8_BAR; }
        if constexpr (!Epi::AFTER_DRAIN) { E(acc, cur, wr, wc, fr, fq); S.done(cur); }
        if (!has_next) break;
#pragma unroll
        for (int a = 0; a < 2; ++a)
#pragma unroll
            for (int b = 0; b < 2; ++b)
#pragma unroll
                for (int m = 0; m < 4; ++m)
#pragma unroll
                    for (int n = 0; n < 2; ++n) acc[a][b][m][n] = (f32x4){0.f, 0.f, 0.f, 0.f};
        cur = nxt; cA = nA; cB = nB; ++ui;
        if constexpr (ALIGN_EPI) { if (wr == 1) PG8_BAR; }
    }
    PG8_WAIT_V(0);
    if constexpr (!ALIGN_EPI) { if (wr == 0) PG8_BAR; }
    PG8_BAR;
    if constexpr (Epi::AFTER_DRAIN) { E.fused(acc, cur, wr, wc, fr, fq, lds, wid, lane); S.done(cur); }
#undef PG8_SA
#undef PG8_SB
#undef PG8_STAGE
#undef PG8_LDA
#undef PG8_LDB
#undef PG8_MMA
#undef PG8_WAIT_V
#undef PG8_WAIT_L
#undef PG8_BAR
#undef PG8_SCHED
}
}

#define PHASE_IDS const int tx = opq_v((int)threadIdx.x); const int bx = opq_s((int)blockIdx.x); const int gx = opq_s((int)gridDim.x); (void)tx; (void)bx; (void)gx;
#define GRID_LOOP(idx, N) for (long idx = (long)bx * 512 + tx; idx < (long)(N); idx += (long)gx * 512)

namespace pg8 {
__device__ __forceinline__ float sigm(float x) { return __builtin_amdgcn_rcpf(1.f + __expf(-x)); }
struct EpiMerge {
    static constexpr bool PERM = false, AFTER_DRAIN = false;
    float* mf; unsigned short* mb; const unsigned short* u; int which; int mode;
    __device__ __forceinline__ void operator()(const f32x4 (&acc)[2][2][4][2], const Unit& un, int wr, int wc, int fr, int fq) const {
        const int row0 = un.pm * BM + wr * 64 + fr, col0 = un.pn * BM + wc * 32 + 4 * fq;
#pragma unroll
        for (int ai = 0; ai < 2; ++ai)
#pragma unroll
            for (int m = 0; m < 4; ++m) { const size_t r = (size_t)(row0 + ai * HALF + m * 16);
#pragma unroll
                for (int bj = 0; bj < 2; ++bj)
#pragma unroll
                    for (int n = 0; n < 2; ++n) { const int c = col0 + bj * HALF + n * 16;
                        const uint2 gw = *(const uint2*)(u + r * 5120 + 2048 + which * 1024 + c);
                        f32x4 g; g[0] = __uint_as_float(gw.x << 16); g[1] = __uint_as_float(gw.x & 0xffff0000u); g[2] = __uint_as_float(gw.y << 16); g[3] = __uint_as_float(gw.y & 0xffff0000u);
                        f32x4 v = g * acc[ai][bj][m][n];
                        float* p = mf + r * 1024 + c;
                        if (mode >= 1) v = v + *(const f32x4*)p;
                        if (mode < 2) *(f32x4*)p = v;
                        else { uint2 w; w.x = cvt_pk_bf16(v[0], v[1]); w.y = cvt_pk_bf16(v[2], v[3]); *(uint2*)(mb + r * 1024 + c) = w; } } }
    }
};
__device__ __forceinline__ float gelu_sig(float x) { return x * sigm(1.5957691216057308f * (x + 0.044715f * x * x * x)); }
struct EpiG1a {
    static constexpr bool PERM = true, AFTER_DRAIN = false;
    unsigned short* uT; unsigned short* btc; unsigned short* btl;
    __device__ __forceinline__ void operator()(const f32x4 (&acc)[2][2][4][2], const Unit& un, int wr, int wc, int fr, int fq) const {
        const int row0 = un.pm * BM + wr * 64 + fr, col0 = wc * 32 + 8 * fq, pn = un.pn;
#pragma unroll
        for (int ai = 0; ai < 2; ++ai)
#pragma unroll
            for (int m = 0; m < 4; ++m) { const int row = row0 + ai * HALF + m * 16;
                unsigned short* base;
                if (un.pm < 6) base = uT + (size_t)row * 8192 + pn * 256;
                else { const int rr = row - 1536, part = rr >> 9, j = rr & 511;
                    if (pn < 16) base = btc + ((size_t)(pn * 512 + j) * 512 + part * 256);
                    else base = btl + ((size_t)(((pn - 16) >> 2) * 512 + j) * 2048 + part * 1024 + ((pn - 16) & 3) * 256); }
#pragma unroll
                for (int bj = 0; bj < 2; ++bj) { const f32x4 v0 = acc[ai][bj][m][0], v1 = acc[ai][bj][m][1];
                    u32x4 w; w.x = cvt_pk_bf16(v0[0], v0[1]); w.y = cvt_pk_bf16(v0[2], v0[3]); w.z = cvt_pk_bf16(v1[0], v1[1]); w.w = cvt_pk_bf16(v1[2], v1[3]);
                    *(u32x4*)(base + bj * HALF + col0) = w; } }
    }
};
struct EpiG1b {
    static constexpr bool PERM = true, AFTER_DRAIN = false;
    unsigned short* u2; int pad0; int pad1;
    __device__ __forceinline__ void operator()(const f32x4 (&acc)[2][2][4][2], const Unit& un, int wr, int wc, int fr, int fq) const {
        const int row0 = un.pm * BM + wr * 64 + fr, col0 = un.pn * BM + wc * 32 + 8 * fq;
        const int act = un.pn < 4 ? 0 : (un.pn < 8 ? 1 : 2);
#pragma unroll
        for (int ai = 0; ai < 2; ++ai)
#pragma unroll
            for (int m = 0; m < 4; ++m) { unsigned short* rowp = u2 + (size_t)(row0 + ai * HALF + m * 16) * 5120 + col0;
#pragma unroll
                for (int bj = 0; bj < 2; ++bj) { f32x4 v0 = acc[ai][bj][m][0], v1 = acc[ai][bj][m][1];
                    if (act == 1) { _Pragma("unroll") for (int e = 0; e < 4; ++e) { v0[e] = gelu_sig(v0[e]); v1[e] = gelu_sig(v1[e]); } }
                    else if (act == 2) { _Pragma("unroll") for (int e = 0; e < 4; ++e) { v0[e] = sigm(v0[e]); v1[e] = sigm(v1[e]); } }
                    u32x4 w; w.x = cvt_pk_bf16(v0[0], v0[1]); w.y = cvt_pk_bf16(v0[2], v0[3]); w.z = cvt_pk_bf16(v1[0], v1[1]); w.w = cvt_pk_bf16(v1[2], v1[3]);
                    *(u32x4*)(rowp + bj * HALF) = w; } }
    }
};
struct EpiFnet {
    static constexpr bool PERM = true, AFTER_DRAIN = false;
    unsigned short* zfn; int L; int tok0;
    __device__ __forceinline__ void operator()(const f32x4 (&acc)[2][2][4][2], const Unit& un, int wr, int wc, int fr, int fq) const {
        const int b = un.pn >> 1, jb = (un.pn & 1) * 256;
        const int row0 = tok0 + b * L + un.pm * BM + wr * 64 + fr, col0 = jb + wc * 32 + 8 * fq;
#pragma unroll
        for (int ai = 0; ai < 2; ++ai)
#pragma unroll
            for (int m = 0; m < 4; ++m) { unsigned short* rowp = zfn + (size_t)(row0 + ai * HALF + m * 16) * 512 + col0;
#pragma unroll
                for (int bj = 0; bj < 2; ++bj) { const f32x4 v0 = acc[ai][bj][m][0], v1 = acc[ai][bj][m][1];
                    u32x4 w; w.x = cvt_pk_bf16(v0[0], v0[1]); w.y = cvt_pk_bf16(v0[2], v0[3]); w.z = cvt_pk_bf16(v1[0], v1[1]); w.w = cvt_pk_bf16(v1[2], v1[3]);
                    *(u32x4*)(rowp + bj * HALF) = w; } }
    }
};
struct EpiResid {
    static constexpr bool PERM = false, AFTER_DRAIN = false;
    float* x; const float* gvec; int gstride; int pad;
    __device__ __forceinline__ void operator()(const f32x4 (&acc)[2][2][4][2], const Unit& un, int wr, int wc, int fr, int fq) const {
        const int row0 = un.pm * BM + wr * 64 + fr, col0 = un.pn * BM + wc * 32 + 4 * fq;
        const int grp = un.pm < 16 ? 0 : 1 + ((un.pm - 16) >> 2);
        f32x4 gv[2][2];
#pragma unroll
        for (int bj = 0; bj < 2; ++bj)
#pragma unroll
            for (int n = 0; n < 2; ++n) gv[bj][n] = *(const f32x4*)(gvec + (size_t)grp * gstride + col0 + bj * HALF + n * 16);
#pragma unroll
        for (int ai = 0; ai < 2; ++ai)
#pragma unroll
            for (int m = 0; m < 4; ++m) { float* rowp = x + (size_t)(row0 + ai * HALF + m * 16) * 1024 + col0;
#pragma unroll
                for (int bj = 0; bj < 2; ++bj)
#pragma unroll
                    for (int n = 0; n < 2; ++n) { float* p = rowp + bj * HALF + n * 16; *(f32x4*)p = *(const f32x4*)p + gv[bj][n] * acc[ai][bj][m][n]; } }
    }
};
struct EpiSwiglu {
    static constexpr bool PERM = true, AFTER_DRAIN = false;
    unsigned short* hm; int ld; int pad;
    __device__ __forceinline__ void operator()(const f32x4 (&acc)[2][2][4][2], const Unit& un, int wr, int wc, int fr, int fq) const {
        const int row0 = un.pm * BM + wr * 64 + fr, col0 = un.pn * HALF + wc * 32 + 8 * fq;
#pragma unroll
        for (int ai = 0; ai < 2; ++ai)
#pragma unroll
            for (int m = 0; m < 4; ++m) {
                f32x4 o0, o1;
#pragma unroll
                for (int e = 0; e < 4; ++e) { const float g0 = acc[ai][0][m][0][e], g1 = acc[ai][0][m][1][e];
                    o0[e] = g0 * sigm(g0) * acc[ai][1][m][0][e]; o1[e] = g1 * sigm(g1) * acc[ai][1][m][1][e]; }
                u32x4 w; w.x = cvt_pk_bf16(o0[0], o0[1]); w.y = cvt_pk_bf16(o0[2], o0[3]); w.z = cvt_pk_bf16(o1[0], o1[1]); w.w = cvt_pk_bf16(o1[2], o1[3]);
                *(u32x4*)(hm + (size_t)(row0 + ai * HALF + m * 16) * ld + col0) = w; }
    }
};
}
#define LAS __attribute__((address_space(3)))
typedef unsigned v4u __attribute__((ext_vector_type(4)));
__device__ __forceinline__ unsigned pk2(float lo, float hi) { return (unsigned)f2bf(lo) | ((unsigned)f2bf(hi) << 16); }
__device__ __forceinline__ void transpose_item(const float* __restrict__ W, int K, int N, bf16_t* __restrict__ WT, int orow0, int k0, int n0, LAS float* scr, int lane) {
#pragma unroll 8
    for (int i = 0; i < 32; ++i) { const int kk = 2 * i + (lane >> 5); scr[kk * 33 + (lane & 31)] = W[(size_t)(k0 + kk) * N + n0 + (lane & 31)]; }
    asm volatile("s_waitcnt lgkmcnt(0)" ::: "memory");
    const int c = lane & 7;
#pragma unroll
    for (int j = 0; j < 4; ++j) { const int n = (lane >> 3) + 8 * j; const LAS float* s = scr + (8 * c) * 33 + n;
        v4u o; o.x = pk2(s[0 * 33], s[1 * 33]); o.y = pk2(s[2 * 33], s[3 * 33]); o.z = pk2(s[4 * 33], s[5 * 33]); o.w = pk2(s[6 * 33], s[7 * 33]);
        *(v4u*)(WT + (size_t)(orow0 + n) * K + k0 + 8 * c) = o; }
    asm volatile("s_waitcnt lgkmcnt(0)" ::: "memory");
}
struct LayerW { bf16_t *win, *wa, *wb, *wc, *wo, *wgu, *wd; };
__device__ __forceinline__ void d_convert(unsigned char* lds, const float* w_in, const float* w_a, const float* w_b, const float* w_c, const float* w_o, const float* w_gu, const float* w_down, const LayerW& o) {
    PHASE_IDS
    const int wave = tx >> 6, lane = tx & 63;
    LAS float* scr = (LAS float*)((LAS unsigned char*)lds + wave * 8448);
    constexpr int I_IN = 16 * 224, I_A = 8 * 32, I_C = 16 * 32, I_GU = 16 * 176, I_D = 44 * 32;
    constexpr int NITEMS = I_IN + 2 * I_A + 2 * I_C + I_GU + I_D;
    for (int it = bx * 8 + wave; it < NITEMS; it += gx * 8) {
        int r = it;
        if (r < I_IN) { const int kb = r / 224, nb = r % 224; const int n0 = nb * 32;
            if (n0 >= 1536 && n0 < 2048) continue;
            transpose_item(w_in, D, DIN, o.win, n0 < 1536 ? n0 : n0 + 512, kb * 64, n0, scr, lane); continue; } r -= I_IN;
        if (r < I_A) { const int kb = r / 32, nb = r % 32; transpose_item(w_a, 512, D, o.wa, nb * 32, kb * 64, nb * 32, scr, lane); continue; } r -= I_A;
        if (r < I_A) { const int kb = r / 32, nb = r % 32; transpose_item(w_b, 512, D, o.wb, nb * 32, kb * 64, nb * 32, scr, lane); continue; } r -= I_A;
        if (r < I_C) { const int kb = r / 32, nb = r % 32; transpose_item(w_c, D, D, o.wc, nb * 32, kb * 64, nb * 32, scr, lane); continue; } r -= I_C;
        if (r < I_C) { const int kb = r / 32, nb = r % 32; transpose_item(w_o, D, D, o.wo, nb * 32, kb * 64, nb * 32, scr, lane); continue; } r -= I_C;
        if (r < I_GU) { const int kb = r / 176, nb = r % 176; const int n0 = nb * 32;
            const int orow = n0 < DFF ? (n0 >> 7) * 256 + (n0 & 127) : ((n0 - DFF) >> 7) * 256 + 128 + ((n0 - DFF) & 127);
            transpose_item(w_gu, D, 2 * DFF, o.wgu, orow, kb * 64, n0, scr, lane); continue; } r -= I_GU;
        { const int kb = r / 32, nb = r % 32; transpose_item(w_down, DFF, D, o.wd, nb * 32, kb * 64, nb * 32, scr, lane); }
    }
}

typedef float f32x4v __attribute__((ext_vector_type(4)));
__device__ __forceinline__ void d_fold_fnet(unsigned char* lds_, const float* __restrict__ w_in, bf16_t* __restrict__ winT) {
    PHASE_IDS
    float* WT = (float*)lds_;
    float* TAB = (float*)(lds_ + 64 * 129 * 4);
    const int lane = tx & 63, wave = tx >> 6, r16 = lane & 15, quad = lane >> 4;
    for (int item = gx - 1 - bx; item < 64; item += gx) {
        const int kb = item >> 2, g = item & 3, k0 = kb * 64;
        __syncthreads();
        if (tx < 128) { float sn, cs; sincospif((float)tx * (2.0f / 128.0f), &sn, &cs); TAB[tx] = cs; TAB[128 + tx] = sn; }
        for (int e = tx; e < 64 * 128; e += 512) { const int kk = e >> 7, cc = e & 127; WT[kk * 129 + cc] = w_in[(size_t)(k0 + kk) * DIN + OFF_FN + g * 128 + cc]; }
        __syncthreads();
#pragma unroll 1
        for (int mi = 0; mi < 2; ++mi) { const int mt = wave * 2 + mi, part = mt >> 3, c0 = (mt & 7) * 16;
            f32x4v acc[4];
#pragma unroll
            for (int nt = 0; nt < 4; ++nt) acc[nt] = (f32x4v){0.f, 0.f, 0.f, 0.f};
            for (int kk0 = 0; kk0 < 128; kk0 += 4) { const int cp = kk0 + quad;
                const float a = TAB[part * 128 + (((c0 + r16) * cp) & 127)];
#pragma unroll
                for (int nt = 0; nt < 4; ++nt) acc[nt] = __builtin_amdgcn_mfma_f32_16x16x4f32(a, WT[(nt * 16 + r16) * 129 + cp], acc[nt], 0, 0, 0); }
#pragma unroll
            for (int nt = 0; nt < 4; ++nt)
#pragma unroll
                for (int j = 0; j < 4; ++j) winT[(size_t)(1536 + part * 512 + g * 128 + c0 + quad * 4 + j) * D + k0 + nt * 16 + r16] = f2bf(acc[nt][j]);
        }
    }
    __syncthreads();
}
__device__ __forceinline__ void d_dftmat(bf16_t* __restrict__ dc, bf16_t* __restrict__ dl) {
    PHASE_IDS
    GRID_LOOP(idx, 256 * 512) { const int lp = (int)(idx >> 9), col = (int)(idx & 511), part = col >> 8, l = col & 255; float sn, cs; sincospif((float)((l * lp) & 255) * (2.0f / 256.0f), &sn, &cs);
        dc[idx] = f2bf((part ? -sn : cs) * 0.005524271728019903f); }
    GRID_LOOP(idx, 1024 * 2048) { const int lp = (int)(idx >> 11), col = (int)(idx & 2047), part = col >> 10, l = col & 1023; float sn, cs; sincospif((float)((l * lp) & 1023) * (2.0f / 1024.0f), &sn, &cs);
        dl[idx] = f2bf((part ? -sn : cs) * 0.0027621358640099515f); }
}
__device__ __forceinline__ void d_mod(const float* __restrict__ c, const float* __restrict__ c_ctx, const float* __restrict__ w_ada, const float* __restrict__ b_ada, float* __restrict__ mod) {
    PHASE_IDS
    GRID_LOOP(idx, DEPTH * 5 * NMOD) {
        const int n = idx % NMOD, g = (idx / NMOD) % 5, l = idx / (NMOD * 5);
        const float* cv = g == 0 ? c_ctx : c + (g - 1) * D;
        float acc = 0.f;
        for (int k = 0; k < D; ++k) { acc += siluf_(cv[k]) * w_ada[((size_t)l * D + k) * NMOD + n]; }
        mod[idx] = acc + b_ada[l * NMOD + n];
    }
}

__device__ __forceinline__ void d_filt_h2(float* lds, const float* __restrict__ fw1, const float* __restrict__ fb1, const float* __restrict__ fw2, const float* __restrict__ fb2, const float* __restrict__ ffreq, float* __restrict__ h2) {
    PHASE_IDS
    const int wave = tx >> 6, j = tx & 63;
    float* feats = lds + wave * 96; float* h1 = feats + 32;
    const int nw = gx * 8;
    for (int base = 0; base < 1280; base += nw) {
        const int r = base + bx * 8 + wave; const bool valid = r < 1280;
        const int L = r < 256 ? 256 : 1024; const int ti = r < 256 ? r : r - 256;
        const float t = (float)ti / (float)L;
        if (valid && j < 17) {
            float f;
            if (j == 0) f = t;
            else if (j <= 8) f = sinf(6.283185307179586f * t * (float)j);
            else f = cosf(6.283185307179586f * t * (float)(j - 8));
            feats[j] = f;
        }
        __syncthreads();
        if (valid) { float a = fb1[j]; for (int k = 0; k < 17; ++k) a += feats[k] * fw1[k * 64 + j]; h1[j] = sinf(ffreq[j] * a); }
        __syncthreads();
        if (valid) { float b = fb2[j]; for (int k = 0; k < 64; ++k) b += h1[k] * fw2[k * 64 + j]; h2[r * 64 + j] = sinf(ffreq[j] * b); }
        __syncthreads();
    }
}
__device__ __forceinline__ void d_norm(const float* __restrict__ x, const float* __restrict__ gw, const float* __restrict__ modl, int sh_off, int sc_off, bf16_t* __restrict__ h) {
    PHASE_IDS
    const int lane = tx & 63;
    for (int m = bx * 8 + (tx >> 6); m < MTOK; m += gx * 8) {
        const RowInfo ri = rowinfo(m);
        const float* xr = x + (size_t)m * D;
        float s = 0.f;
        for (int i = 0; i < 16; ++i) { const float v = xr[lane + 64 * i]; s += v * v; }
        for (int o = 1; o < 64; o <<= 1) s += __shfl_xor(s, o);
        const float rs = rsqrtf(s * (1.f / D) + EPS);
        const float* mg = modl + ri.grp * NMOD;
        for (int i = 0; i < 16; ++i) { const int k = lane + 64 * i; h[(size_t)m * D + k] = f2bf(xr[k] * rs * gw[k] * (1.f + mg[sc_off + k]) + mg[sh_off + k]); }
    }
}
__device__ __forceinline__ void d_final(const float* __restrict__ x, const float* __restrict__ gw, float* __restrict__ out) {
    PHASE_IDS
    const int lane = tx & 63;
    for (int m = bx * 8 + (tx >> 6); m < MTOK; m += gx * 8) {
        const float* xr = x + (size_t)m * D;
        float s = 0.f;
        for (int i = 0; i < 16; ++i) { const float v = xr[lane + 64 * i]; s += v * v; }
        for (int o = 1; o < 64; o <<= 1) s += __shfl_xor(s, o);
        const float rs = rsqrtf(s * (1.f / D) + EPS);
        for (int i = 0; i < 16; ++i) { const int k = lane + 64 * i; out[(size_t)m * D + k] = xr[k] * rs * gw[k]; }
    }
}

__device__ __forceinline__ void d_filt_h3T(const float* __restrict__ h2, const float* __restrict__ fw3, float* __restrict__ krawT) {
    PHASE_IDS
    GRID_LOOP(idx, 2048 * 1280) {
        const int r = (int)(idx % 1280), j = (int)(idx / 1280);
        const int L = r < 256 ? 256 : 1024; const int ti = r < 256 ? r : r - 256;
        const float t = (float)ti / (float)L;
        float acc = 0.f;
        for (int k = 0; k < 64; ++k) acc += h2[r * 64 + k] * fw3[k * 2048 + j];
        const int c = j & 511;
        const float delta = DECAY_SLOW + (DECAY_FAST - DECAY_SLOW) * ((float)c / 511.0f);
        krawT[idx] = acc * expf(-t * delta);
    }
}
constexpr int RT_LAT0 = 2 * 512 * 512, RT_LAYER = RT_LAT0 + 2 * 512 * 2048;
__device__ __forceinline__ void d_filt_build(const float* __restrict__ krawT, bf16_t* __restrict__ rt) {
    PHASE_IDS
    const int lane = tx & 63;
    for (int task = bx * 8 + (tx >> 6); task < 2048; task += gx * 8) {
        const int c = task & 511, o = (task >> 9) & 1, ls = task >> 10;
        const int L = ls ? 1024 : 256, r0 = ls ? 256 : 0;
        const float* fw = krawT + (size_t)(o * 1024 + c) * 1280 + r0;
        const float* bw = krawT + (size_t)(o * 1024 + 512 + c) * 1280 + r0;
        float ss = 0.f;
        for (int t = lane; t < L; t += 64) { const float f = fw[t]; ss += f * f; if (t >= 1) { const float b = bw[t]; ss += b * b; } }
        for (int of = 1; of < 64; of <<= 1) ss += __shfl_xor(ss, of);
        const float sc = rsqrtf(ss + EPS);
        bf16_t* dst = rt + (ls ? RT_LAT0 + (size_t)(o * 512 + c) * 2048 : (size_t)(o * 512 + c) * 512);
        for (int p = lane; p < 2 * L; p += 64) { float v = 0.f; if (p >= 1 && p <= L) v = fw[L - p]; else if (p > L) v = bw[p - L]; dst[p] = f2bf(v * sc); }
    }
}

typedef float f32x16 __attribute__((ext_vector_type(16)));
__device__ __forceinline__ void unpack8(const uint4 v, float* f) {
    f[0] = __uint_as_float(v.x << 16); f[1] = __uint_as_float(v.x & 0xffff0000u); f[2] = __uint_as_float(v.y << 16); f[3] = __uint_as_float(v.y & 0xffff0000u);
    f[4] = __uint_as_float(v.z << 16); f[5] = __uint_as_float(v.z & 0xffff0000u); f[6] = __uint_as_float(v.w << 16); f[7] = __uint_as_float(v.w & 0xffff0000u);
}
template <bool LAT>
__device__ __forceinline__ void hy_unit(unsigned char* lds_, const int tx, const bf16_t* __restrict__ uT, const float* __restrict__ hcw, const float* __restrict__ hcb, const float* __restrict__ hbias,
                                        const bf16_t* __restrict__ rt, const int c0, bf16_t* __restrict__ zhy) {
    constexpr int B = LAT ? 4 : 16, L = LAT ? 1024 : 256, ZPAD = LAT ? 224 : 32, LZ = L + 2 * ZPAD, TOK0 = LAT ? MCTX : 0, ND = LAT ? 78 : 18, CPS = 2 * L + 32;
    bf16_t* CP = (bf16_t*)lds_;
    bf16_t* ZB = (bf16_t*)(lds_ + 66560);
    bf16_t* X1 = (bf16_t*)(lds_ + 66560 + 23552);
    bf16_t* X2 = X1 + 2 * 4096;
    const int lane = tx & 63, wave = tx >> 6, ch = wave >> 2, wq = wave & 3, r = lane & 31, h = lane >> 5;
    __syncthreads();
    { constexpr int PER = 2 * ZPAD / 8, NZ = 2 * B * PER;
      for (int e = tx; e < NZ; e += 512) { const int rowi = e / PER, k = e % PER; const int off = k < ZPAD / 8 ? k * 8 : ZPAD + L + (k - ZPAD / 8) * 8;
          *(uint4*)&ZB[rowi * LZ + off] = make_uint4(0u, 0u, 0u, 0u); } }
#pragma unroll 1
    for (int i = 0; i < 6; ++i) { const int e = tx + 512 * i, cc = e / 1536, rtp = (e >> 9) % 3, chunk = e & 511, tok = chunk * 8, b = tok / L, t = tok % L;
        const int row = rtp * 512 + c0 + cc;
        const bf16_t* src = uT + (size_t)row * 8192 + TOK0 + tok;
        float x[10]; unpack8(*(const uint4*)src, x + 1);
        x[0] = t > 0 ? bf2f(src[-1]) : 0.f; x[9] = t + 8 < L ? bf2f(src[8]) : 0.f;
        const float w0 = hcw[row], w1 = hcw[1536 + row], w2 = hcw[3072 + row], cb = hcb[row];
        float o[8];
#pragma unroll
        for (int j = 0; j < 8; ++j) o[j] = cb + w0 * x[j] + w1 * x[j + 1] + w2 * x[j + 2];
        uint4 pk; pk.x = pk2(o[0], o[1]); pk.y = pk2(o[2], o[3]); pk.z = pk2(o[4], o[5]); pk.w = pk2(o[6], o[7]);
        bf16_t* dst = rtp == 0 ? &ZB[(cc * B + b) * LZ + ZPAD + t] : (rtp == 1 ? &X1[cc * 4096 + tok] : &X2[cc * 4096 + tok]);
        *(uint4*)dst = pk; }
    const float bias0 = hbias[c0 + ch], bias1 = hbias[512 + c0 + ch];
    const int tau = LAT ? 8 * wq + (r >> 2) : 2 * wq + (r >> 4), b = LAT ? (r & 3) : (r & 15);
    const int d16hi = LAT ? 16 * wq + 14 : 4 * wq + 2;
    const bf16_t* pa = CP + (ch * 8 + ((8 - (r & 7)) & 7)) * CPS + (L - 16 * d16hi - ((r + 7) & ~7) + 8 * h);
    const bf16_t* pb = ZB + (ch * B + b) * LZ + ZPAD + 16 * (2 * tau - d16hi) + 8 * h;
    uint2 zpk[4];
#pragma unroll 1
    for (int o = 0; o < 2; ++o) {
        for (int e = tx; e < 2 * (2 * L / 8); e += 512) { const int cc = e / (2 * L / 8), a = e % (2 * L / 8);
            const bf16_t* src = rt + (LAT ? RT_LAT0 + (size_t)(o * 512 + c0 + cc) * 2048 : (size_t)(o * 512 + c0 + cc) * 512) + a * 8;
            const uint4 lo = *(const uint4*)src; const uint4 hi = (a + 1 < 2 * L / 8) ? *(const uint4*)(src + 8) : make_uint4(0u, 0u, 0u, 0u);
            const unsigned w[8] = {lo.x, lo.y, lo.z, lo.w, hi.x, hi.y, hi.z, hi.w};
#pragma unroll
            for (int rho = 0; rho < 8; ++rho) { uint4 q;
                if ((rho & 1) == 0) { q.x = w[rho / 2]; q.y = w[rho / 2 + 1]; q.z = w[rho / 2 + 2]; q.w = w[rho / 2 + 3]; }
                else { const int k = rho / 2; q.x = (w[k] >> 16) | (w[k + 1] << 16); q.y = (w[k + 1] >> 16) | (w[k + 2] << 16); q.z = (w[k + 2] >> 16) | (w[k + 3] << 16); q.w = (w[k + 3] >> 16) | (w[k + 4] << 16); }
                *(uint4*)&CP[(cc * 8 + rho) * CPS + a * 8] = q; } }
        if (o == 0) { for (int e = tx; e < 2 * 8 * 4; e += 512) { const int cr = e >> 2, k = e & 3; *(uint4*)&CP[cr * CPS + 2 * L + k * 8] = make_uint4(0u, 0u, 0u, 0u); } }
        else {
#pragma unroll
            for (int g = 0; g < 4; ++g) *(uint2*)&ZB[(ch * B + b) * LZ + ZPAD + 32 * tau + 8 * g + 4 * h] = zpk[g]; }
        __syncthreads();
        f32x16 acc;
#pragma unroll
        for (int i = 0; i < 16; ++i) acc[i] = 0.f;
#pragma unroll 6
        for (int i = 0; i < ND; ++i) acc = __builtin_amdgcn_mfma_f32_32x32x16_bf16(*(const bf16x8*)(pa + 16 * i), *(const bf16x8*)(pb + 16 * i), acc, 0, 0, 0);
        const bf16_t* gate = (o == 0 ? X1 : X2) + ch * 4096 + b * L;
        const float bias = o == 0 ? bias0 : bias1;
#pragma unroll
        for (int g = 0; g < 4; ++g) { const int t4 = 32 * tau + 8 * g + 4 * h;
            const uint2 zv = *(const uint2*)&ZB[(ch * B + b) * LZ + ZPAD + t4], gv = *(const uint2*)&gate[t4];
            const float z0 = __uint_as_float(zv.x << 16), z1 = __uint_as_float(zv.x & 0xffff0000u), z2 = __uint_as_float(zv.y << 16), z3 = __uint_as_float(zv.y & 0xffff0000u);
            const float g0 = __uint_as_float(gv.x << 16), g1 = __uint_as_float(gv.x & 0xffff0000u), g2 = __uint_as_float(gv.y << 16), g3 = __uint_as_float(gv.y & 0xffff0000u);
            const float r0 = g0 * (acc[4 * g] + bias * z0), r1 = g1 * (acc[4 * g + 1] + bias * z1), r2 = g2 * (acc[4 * g + 2] + bias * z2), r3 = g3 * (acc[4 * g + 3] + bias * z3);
            if (o == 0) { zpk[g].x = pk2(r0, r1); zpk[g].y = pk2(r2, r3); }
            else { bf16_t* dst = zhy + (size_t)(TOK0 + b * L + t4) * 512 + c0 + ch; dst[0] = f2bf(r0); dst[512] = f2bf(r1); dst[1024] = f2bf(r2); dst[1536] = f2bf(r3); } }
        __syncthreads();
    }
}
__device__ __forceinline__ void d_hyena(unsigned char* lds_, const bf16_t* __restrict__ uT, const float* __restrict__ hcw, const float* __restrict__ hcb, const float* __restrict__ hbias, const bf16_t* __restrict__ rt, bf16_t* __restrict__ zhy) {
    PHASE_IDS
    for (int pu = bx; pu < 256; pu += gx) {
        hy_unit<true>(lds_, tx, uT, hcw, hcb, hbias, rt, 2 * pu, zhy);
        hy_unit<false>(lds_, tx, uT, hcw, hcb, hbias, rt, 2 * pu, zhy);
    }
    __syncthreads();
}

__device__ __forceinline__ void d_rg_fast(unsigned char* lds_, const bf16_t* __restrict__ u, const float* __restrict__ cw, const float* __restrict__ cb,
                                          const float* __restrict__ wr, const float* __restrict__ br, const float* __restrict__ wi, const float* __restrict__ bi, const float* __restrict__ lam,
                                          const float* __restrict__ state, int layer, float* __restrict__ hf, bf16_t* __restrict__ zrg, float* __restrict__ new_state) {
    PHASE_IDS
    constexpr int AP = 136;
    bf16_t* ACH = (bf16_t*)lds_;
    float* XR32 = (float*)(lds_ + 34816);
    bf16_t* BT = (bf16_t*)(lds_ + 51200);
    float* AB = (float*)(lds_ + 68608);
    float* SEG = (float*)(lds_ + 101376);
    float* CARRY = (float*)(lds_ + 105472);
    float* CWL = (float*)(lds_ + 105728);
    const int lane = tx & 63, wave = tx >> 6, r16 = lane & 15, quad = lane >> 4;
    const int kg = tx & 15, tr = tx >> 4;
    const int chain = tx & 31, seg = tx >> 5;
    for (int unit = bx; unit < 256; unit += gx) {
        const int s = unit >> 5, n = (unit >> 2) & 7, q = unit & 3;
        const bool isctx = s < 4;
        const int row0 = s * 1024, Ls = isctx ? 256 : 1024, ch0 = n * 128 + q * 32;
        __syncthreads();
        for (int e = tx; e < 640; e += 512) { const int k = e >> 7, cc = e & 127; CWL[e] = k < 4 ? cw[k * 1024 + n * 128 + cc] : cb[n * 128 + cc]; }
        for (int dir = 0; dir < 2; ++dir) {
            __syncthreads();
#pragma unroll 4
            for (int i = 0; i < 16; ++i) { const int e = tx + 512 * i, gate = e >> 12, k = (e >> 5) & 127, c = e & 31;
                const float* W = gate ? wi : wr;
                BT[(gate * 32 + c) * AP + k] = f2bf(W[((size_t)(dir * 8 + n) * 128 + k) * 128 + q * 32 + c]); }
            if (tx < 32) CARRY[tx] = isctx ? 0.f : state[((size_t)((s - 4) * DEPTH + layer) * 2 + dir) * DRG + ch0 + tx];
            __syncthreads();
            float brv[2], biv[2], sp8[2];
#pragma unroll
            for (int h2 = 0; h2 < 2; ++h2) { const int ch = dir * 1024 + ch0 + h2 * 16 + r16; brv[h2] = br[ch]; biv[h2] = bi[ch]; sp8[h2] = 8.0f * log1pf(expf(-lam[ch])); }
            for (int ci = 0; ci < 8; ++ci) {
                const int c = dir ? 7 - ci : ci; const int tbase = row0 + c * 128;
                {
                    const int t0 = tbase + tr * 4;
                    const int seq_lo = row0 + ((t0 - row0) / Ls) * Ls, seq_hi = seq_lo + Ls;
                    float in[7][8];
#pragma unroll
                    for (int j = 0; j < 7; ++j) { const int row = t0 - 2 + j;
                        uint4 v = make_uint4(0u, 0u, 0u, 0u);
                        if (row >= seq_lo && row < seq_hi) v = *(const uint4*)(u + (size_t)row * 5120 + n * 128 + kg * 8);
                        in[j][0] = __uint_as_float(v.x << 16); in[j][1] = __uint_as_float(v.x & 0xffff0000u); in[j][2] = __uint_as_float(v.y << 16); in[j][3] = __uint_as_float(v.y & 0xffff0000u);
                        in[j][4] = __uint_as_float(v.z << 16); in[j][5] = __uint_as_float(v.z & 0xffff0000u); in[j][6] = __uint_as_float(v.w << 16); in[j][7] = __uint_as_float(v.w & 0xffff0000u); }
                    float cwv[4][8], cbv[8];
#pragma unroll
                    for (int k = 0; k < 4; ++k) { const float4 w0 = *(const float4*)&CWL[k * 128 + kg * 8], w1 = *(const float4*)&CWL[k * 128 + kg * 8 + 4];
                        cwv[k][0] = w0.x; cwv[k][1] = w0.y; cwv[k][2] = w0.z; cwv[k][3] = w0.w; cwv[k][4] = w1.x; cwv[k][5] = w1.y; cwv[k][6] = w1.z; cwv[k][7] = w1.w; }
                    { const float4 w0 = *(const float4*)&CWL[512 + kg * 8], w1 = *(const float4*)&CWL[512 + kg * 8 + 4];
                        cbv[0] = w0.x; cbv[1] = w0.y; cbv[2] = w0.z; cbv[3] = w0.w; cbv[4] = w1.x; cbv[5] = w1.y; cbv[6] = w1.z; cbv[7] = w1.w; }
#pragma unroll
                    for (int j = 0; j < 4; ++j) { float o[8];
#pragma unroll
                        for (int e = 0; e < 8; ++e) o[e] = cbv[e] + in[j][e] * cwv[0][e] + in[j + 1][e] * cwv[1][e] + in[j + 2][e] * cwv[2][e] + in[j + 3][e] * cwv[3][e];
                        uint4 pk; pk.x = pk2(o[0], o[1]); pk.y = pk2(o[2], o[3]); pk.z = pk2(o[4], o[5]); pk.w = pk2(o[6], o[7]);
                        *(uint4*)&ACH[(tr * 4 + j) * AP + kg * 8] = pk;
                        if ((kg >> 2) == q) { float* xp = &XR32[(tr * 4 + j) * 32 + (kg & 3) * 8]; *(float4*)xp = make_float4(o[0], o[1], o[2], o[3]); *(float4*)(xp + 4) = make_float4(o[4], o[5], o[6], o[7]); } }
                }
                __syncthreads();
                {
                    f32x4 acc[4];
#pragma unroll
                    for (int nt = 0; nt < 4; ++nt) acc[nt] = (f32x4){0.f, 0.f, 0.f, 0.f};
#pragma unroll
                    for (int ks = 0; ks < 4; ++ks) { const bf16x8 a = *(const bf16x8*)&ACH[(wave * 16 + r16) * AP + ks * 32 + quad * 8];
#pragma unroll
                        for (int nt = 0; nt < 4; ++nt) { const bf16x8 b = *(const bf16x8*)&BT[(nt * 16 + r16) * AP + ks * 32 + quad * 8]; acc[nt] = __builtin_amdgcn_mfma_f32_16x16x32_bf16(a, b, acc[nt], 0, 0, 0); } }
#pragma unroll
                    for (int h2 = 0; h2 < 2; ++h2)
#pragma unroll
                        for (int j = 0; j < 4; ++j) { const int tl = wave * 16 + quad * 4 + j, cc = h2 * 16 + r16;
                            const float rg = sigmoidf_(acc[h2][j] + brv[h2]), ig = sigmoidf_(acc[2 + h2][j] + biv[h2]);
                            const float log_a = -rg * sp8[h2];
                            const float a = expf(log_a);
                            float mult = sqrtf(fmaxf(-expm1f(2.0f * log_a), 0.f));
                            if (isctx) { const int pos = (tbase + tl) & 255; if ((dir == 0 && pos == 0) || (dir == 1 && pos == 255)) mult = 1.0f; }
                            AB[tl * 64 + cc] = a; AB[tl * 64 + 32 + cc] = mult * ig * XR32[tl * 32 + cc]; }
                }
                __syncthreads();
                const int rank = dir ? 15 - seg : seg;
                {
                    float A = 1.f, B = 0.f;
#pragma unroll
                    for (int i = 0; i < 8; ++i) { const int tl = seg * 8 + (dir ? 7 - i : i); const float a = AB[tl * 64 + chain], b = AB[tl * 64 + 32 + chain]; B = a * B + b; A = A * a; }
                    SEG[(rank * 32 + chain) * 2] = A; SEG[(rank * 32 + chain) * 2 + 1] = B;
                }
                __syncthreads();
                {
                    const bool newseq = isctx && ((c & 1) == dir);
                    float h = newseq ? 0.f : CARRY[(ci & 1) * 32 + chain];
                    for (int rr = 0; rr < rank; ++rr) h = SEG[(rr * 32 + chain) * 2] * h + SEG[(rr * 32 + chain) * 2 + 1];
#pragma unroll
                    for (int i = 0; i < 8; ++i) { const int tl = seg * 8 + (dir ? 7 - i : i); const float a = AB[tl * 64 + chain], b = AB[tl * 64 + 32 + chain]; h = a * h + b;
                        const size_t tok = (size_t)(tbase + tl);
                        if (dir == 0) hf[tok * DRG + ch0 + chain] = h;
                        else { const float gy = bf2f(u[tok * 5120 + 1024 + ch0 + chain]); zrg[tok * DRG + ch0 + chain] = f2bf((hf[tok * DRG + ch0 + chain] + h) * gy); } }
                    if (rank == 15) { CARRY[((ci + 1) & 1) * 32 + chain] = h;
                        if (isctx && ((c & 1) != dir)) new_state[((size_t)((s * 4 + (c >> 1)) * DEPTH + layer) * 2 + dir) * DRG + ch0 + chain] = h; }
                }
            }
        }
    }
    __syncthreads();
}

struct Params { const float* in[33]; float* out; unsigned char* ws; };
constexpr int LDS_BYTES = 147456;
constexpr size_t MiB = (size_t)1 << 20;
constexpr size_t WS_MOD = 0, WS_H2 = 2 * MiB, WS_X = 13 * MiB, WS_XN = 45 * MiB, WS_MF = 61 * MiB, WS_ZHY = 93 * MiB, WS_ZFN = 101 * MiB, WS_ZRG = 109 * MiB,
                 WS_W = 125 * MiB, WS_DFTC = 163 * MiB, WS_DFTL = 164 * MiB, WS_BIG = 168 * MiB, WS_RT = 288 * MiB, WS_END = WS_RT + 20 * MiB;
constexpr size_t WO_IN = 0, WO_A = WO_IN + (size_t)7680 * D, WO_B = WO_A + (size_t)D * 512, WO_C = WO_B + (size_t)D * 512, WO_O = WO_C + (size_t)D * D, WO_GU = WO_O + (size_t)D * D, WO_D = WO_GU + (size_t)2 * DFF * D, WO_END = WO_D + (size_t)D * DFF;
static_assert(WO_END * 2 <= 38 * MiB, "weight copies");

#define GEMM_PHASE(EpiT, g, E, ALIGN) do { pg8::StaticOrder S_; S_.init((g).M, (g).N, opq_s((int)gridDim.x), opq_s((int)blockIdx.x)); pg8::gemm_phase<EpiT, pg8::StaticOrder, ALIGN, true>(ldsp, g, S_, E); } while (0)

#define IN(i) (p.in[opq_s(i)])
#define WSB(off) (p.ws + (size_t)opq_s((int)((off) >> 20)) * MiB)
__global__ void __launch_bounds__(512, 2) mega(Params p) {
    cg::grid_group grid = cg::this_grid();
    extern __shared__ __attribute__((aligned(16))) unsigned char lds[];
    PG8_LAS unsigned char* ldsp = (PG8_LAS unsigned char*)lds;
#define P_X      ((float*)WSB(WS_X))
#define P_XN     ((bf16_t*)WSB(WS_XN))
#define P_MF     ((float*)WSB(WS_MF))
#define P_ZHY    ((bf16_t*)WSB(WS_ZHY))
#define P_ZFN    ((bf16_t*)WSB(WS_ZFN))
#define P_ZRG    ((bf16_t*)WSB(WS_ZRG))
#define P_WL     ((bf16_t*)WSB(WS_W))
#define P_UT     ((bf16_t*)WSB(WS_BIG))
#define P_U2     ((bf16_t*)WSB(WS_BIG + 24 * MiB))
#define P_BTC    ((bf16_t*)WSB(WS_BIG + 104 * MiB))
#define P_BTL    ((bf16_t*)WSB(WS_BIG + 112 * MiB))
#define P_RT     ((bf16_t*)WSB(WS_RT))
#define P_DFTC   ((bf16_t*)WSB(WS_DFTC))
#define P_DFTL   ((bf16_t*)WSB(WS_DFTL))
#define P_MOD    ((float*)WSB(WS_MOD))
#define P_H2     ((float*)WSB(WS_H2))
#define P_GB     (p.out)
#define P_NS     (p.out + (size_t)2 * MCTX * D)
    { PHASE_IDS
      float* x = P_X; const float* xp = IN(0); const float* xs = IN(1);
      GRID_LOOP(i, (long)MCTX * D / 4) ((float4*)x)[i] = ((const float4*)xp)[i];
      GRID_LOOP(i, (long)MLAT * D / 4) ((float4*)(x + (size_t)MCTX * D))[i] = ((const float4*)xs)[i]; }
    d_mod(IN(2), IN(4), IN(7), IN(8), P_MOD);
    d_dftmat(P_DFTC, P_DFTL);
    for (int l0 = 0; l0 < DEPTH; ++l0) { const int l = opq_s(l0); d_filt_h2((float*)lds, IN(12) + l * 17 * 64, IN(13) + l * 64, IN(14) + l * 64 * 64, IN(15) + l * 64, IN(17) + l * 64, P_H2 + (size_t)l * 1280 * 64); }
    grid.sync();
    for (int l0 = 0; l0 < DEPTH; ++l0) { const int l = opq_s(l0); d_filt_h3T(P_H2 + (size_t)l * 1280 * 64, IN(16) + (size_t)l * 64 * 2048, (float*)WSB(WS_BIG) + (size_t)l * 2048 * 1280); }
    grid.sync();
    for (int l0 = 0; l0 < DEPTH; ++l0) { const int l = opq_s(l0); d_filt_build((const float*)WSB(WS_BIG) + (size_t)l * 2048 * 1280, P_RT + (size_t)l * RT_LAYER); }
    grid.sync();
    for (int l0 = 0; l0 < DEPTH; ++l0) {
        const int l = opq_s(l0);
        { bf16_t* wl = P_WL; const LayerW LW{wl + WO_IN, wl + WO_A, wl + WO_B, wl + WO_C, wl + WO_O, wl + WO_GU, wl + WO_D};
          d_convert(lds, IN(9) + (size_t)l * D * DIN, IN(19) + (size_t)l * 512 * D, IN(20) + (size_t)l * 512 * D, IN(28) + (size_t)l * D * D, IN(29) + (size_t)l * D * D, IN(30) + (size_t)l * D * 2 * DFF, IN(31) + (size_t)l * DFF * D, LW); }
        __syncthreads();
        d_fold_fnet(lds, IN(9) + (size_t)l * D * DIN, P_WL + WO_IN);
        d_norm(P_X, IN(5) + l * D, P_MOD + (size_t)l * 5 * NMOD, 0, D, P_XN);
        grid.sync();
        { const pg8::Gemm g{P_WL + WO_IN, P_XN, 2560, MTOK, D}; const pg8::EpiG1a E{P_UT, P_BTC, P_BTL}; GEMM_PHASE(pg8::EpiG1a, g, E, true); }
        { const pg8::Gemm g{P_XN, P_WL + WO_IN + (size_t)2560 * D, MTOK, 5120, D}; const pg8::EpiG1b E{P_U2, 0, 0}; GEMM_PHASE(pg8::EpiG1b, g, E, true); }
        grid.sync();
        d_hyena(lds, P_UT, IN(10) + l * 3 * 1536, IN(11) + l * 1536, IN(18) + l * 1024, P_RT + (size_t)l * RT_LAYER, P_ZHY);
        d_rg_fast(lds, P_U2, IN(21) + l * 4 * 1024, IN(22) + l * 1024, IN(23) + (size_t)l * 2 * 8 * 128 * 128, IN(24) + l * 2048, IN(25) + (size_t)l * 2 * 8 * 128 * 128, IN(26) + l * 2048, IN(27) + l * 2048, IN(3), l, P_MF, P_ZRG, P_NS);
        { const pg8::Gemm g{P_DFTC, P_BTC, 256, 8192, 512}; const pg8::EpiFnet E{P_ZFN, 256, 0}; GEMM_PHASE(pg8::EpiFnet, g, E, false); }
        { const pg8::Gemm g{P_DFTL, P_BTL, 1024, 2048, 2048}; const pg8::EpiFnet E{P_ZFN, 1024, MCTX}; pg8::StaticOrder S_; S_.init(1024, 2048, opq_s((int)gridDim.x), (opq_s((int)blockIdx.x) + (int)gridDim.x - 32) % (int)gridDim.x); pg8::gemm_phase<pg8::EpiFnet, pg8::StaticOrder, false, true>(ldsp, g, S_, E); }
        grid.sync();
        { const pg8::Gemm g{P_ZHY, P_WL + WO_A, MTOK, D, 512}; const pg8::EpiMerge E{P_MF, P_XN, P_U2, 0, 0}; GEMM_PHASE(pg8::EpiMerge, g, E, false); }
        { const pg8::Gemm g{P_ZFN, P_WL + WO_B, MTOK, D, 512}; const pg8::EpiMerge E{P_MF, P_XN, P_U2, 1, 1}; GEMM_PHASE(pg8::EpiMerge, g, E, false); }
        { const pg8::Gemm g{P_ZRG, P_WL + WO_C, MTOK, D, D}; const pg8::EpiMerge E{P_MF, P_XN, P_U2, 2, 2}; GEMM_PHASE(pg8::EpiMerge, g, E, false); }
        grid.sync();
        { const pg8::Gemm g{P_XN, P_WL + WO_O, MTOK, D, D}; const pg8::EpiResid E{P_X, P_MOD + (size_t)l * 5 * NMOD + 2 * D, NMOD, 0}; GEMM_PHASE(pg8::EpiResid, g, E, false); }
        grid.sync();
        d_norm(P_X, IN(6) + l * D, P_MOD + (size_t)l * 5 * NMOD, 3 * D, 4 * D, P_XN);
        grid.sync();
        { const pg8::Gemm g{P_XN, P_WL + WO_GU, MTOK, 2 * DFF, D}; const pg8::EpiSwiglu E{P_U2, DFF, 0}; GEMM_PHASE(pg8::EpiSwiglu, g, E, true); }
        grid.sync();
        { const pg8::Gemm g{P_U2, P_WL + WO_D, MTOK, D, DFF}; const pg8::EpiResid E{P_X, P_MOD + (size_t)l * 5 * NMOD + 5 * D, NMOD, 0}; GEMM_PHASE(pg8::EpiResid, g, E, false); }
        grid.sync();
    }
    d_final(P_X, IN(32), p.out);
}

extern "C" void kernel_launch(void* const* d_in, const int* in_sizes, int n_in, void* d_out, int out_size, void* d_ws, size_t ws_size, hipStream_t stream) {
    static int grid_blocks = 0;
    if (grid_blocks == 0) {
        if (n_in != 33 || ws_size < WS_END) { fprintf(stderr, "kernel_launch: unexpected n_in %d or ws_size %zu (need %zu)\n", n_in, ws_size, (size_t)WS_END); grid_blocks = -1; return; }
        int dev = 0, cus = 0, per_cu = 0;
        (void)hipGetDevice(&dev);
        (void)hipDeviceGetAttribute(&cus, hipDeviceAttributeMultiprocessorCount, dev);
        (void)hipFuncSetAttribute((const void*)mega, hipFuncAttributeMaxDynamicSharedMemorySize, LDS_BYTES);
        (void)hipOccupancyMaxActiveBlocksPerMultiprocessor(&per_cu, (const void*)mega, 512, LDS_BYTES);
        if (per_cu < 1 || cus < 1) { fprintf(stderr, "kernel_launch: occupancy query gave %d blocks/CU on %d CUs\n", per_cu, cus); grid_blocks = -1; return; }
        grid_blocks = cus * per_cu;
    }
    if (grid_blocks < 0) return;
    Params p{};
    for (int i = 0; i < 33; ++i) p.in[i] = (const float*)d_in[i];
    p.out = (float*)d_out; p.ws = (unsigned char*)d_ws;
    void* args[] = {&p};
    hipError_t e = hipLaunchCooperativeKernel((const void*)mega, dim3(grid_blocks), dim3(512), args, LDS_BYTES, stream);
    if (e != hipSuccess) fprintf(stderr, "cooperative launch failed: %s (grid %d)\n", hipGetErrorString(e), grid_blocks);
}
```

```cpp
#include <hip/hip_runtime.h>
#include <cstdint>
#include <cstdio>
#include <cmath>
#include <hip/hip_cooperative_groups.h>
namespace cg = cooperative_groups;

constexpr int D = 1024, DEPTH = 4;
constexpr int NCTX = 16, LCTX = 256, NLAT = 4, LLAT = 1024;
constexpr int MCTX = NCTX * LCTX, MLAT = NLAT * LLAT, MTOK = MCTX + MLAT;
constexpr int DHY = 512, DFN = 512, DRG = 1024, DFF = 2816, DIN = 7168;
constexpr int OFF_HY = 0, OFF_FN = 1536, OFF_RX = 2048, OFF_RY = 3072, OFF_G = 4096;
constexpr int NMOD = 6 * D;
constexpr float EPS = 1e-6f;
constexpr float DECAY_SLOW = 3.0701134573253945f;
constexpr float DECAY_FAST = 15.350567286626972f;

typedef short bf16x8 __attribute__((ext_vector_type(8)));
typedef float f32x4 __attribute__((ext_vector_type(4)));
typedef unsigned short bf16_t;

__device__ __forceinline__ bf16_t f2bf(float f) { unsigned u = __float_as_uint(f); return (bf16_t)((u + 0x7fffu + ((u >> 16) & 1u)) >> 16); }
__device__ __forceinline__ float bf2f(bf16_t h) { return __uint_as_float(((unsigned)h) << 16); }
__device__ __forceinline__ float sigmoidf_(float x) { return 1.f / (1.f + __expf(-x)); }
__device__ __forceinline__ float siluf_(float x) { return x / (1.f + __expf(-x)); }
__device__ __forceinline__ float gelu_tanh(float x) { const float u = 0.7978845608028654f * (x + 0.044715f * x * x * x); return 0.5f * x * (1.f + tanhf(u)); }

struct RowInfo { int grp, t, L, s0, lset, frow; };
__device__ __forceinline__ RowInfo rowinfo(int m) {
    RowInfo r;
    if (m < MCTX) { r.grp = 0; r.t = m & 255; r.L = LCTX; r.s0 = m - r.t; r.lset = 0; r.frow = 0; }
    else { const int mm = m - MCTX; r.grp = 1 + (mm >> 10); r.t = mm & 1023; r.L = LLAT; r.s0 = m - r.t; r.lset = 1; r.frow = 256; }
    return r;
}


__device__ __forceinline__ int opq_v(int v) { asm volatile("" : "+v"(v)); return v; }
__device__ __forceinline__ int opq_s(int v) { asm volatile("" : "+s"(v)); return v; }
namespace pg8 {
#define PG8_LAS __attribute__((address_space(3)))
typedef unsigned short bf16_t;
typedef short bf16x8 __attribute__((ext_vector_type(8)));
typedef float f32x4 __attribute__((ext_vector_type(4)));
typedef unsigned u32x4 __attribute__((ext_vector_type(4)));
constexpr int BM = 256, BK = 64, HALF = 128, HTB = HALF * BK * 2  , STAGE_BYTES = 8 * HTB, NXCD = 8, WGM = 8;

__host__ __device__ __forceinline__ int lds_byte(int r, int c) { const int st = (r >> 4) * 2 + (c >> 5), rr = r & 15, cc = c & 31, ob = rr * 64 + cc * 2; return st * 1024 + (ob ^ (((ob >> 9) & 1) << 5)); }
__host__ __device__ __forceinline__ void stage_rc(int b, int& R, int& C) { const int st = b / 1024, sb = b % 1024, swz = sb ^ (((sb >> 9) & 1) << 5); R = (st >> 1) * 16 + swz / 64; C = (st & 1) * 32 + (swz % 64) / 2; }
__host__ __device__ __forceinline__ int perm32(int rho) { const int n = rho >> 4, i = rho & 15; return 8 * (i >> 2) + 4 * n + (i & 3); }

struct Unit { int pm, pn; };
struct Gemm { const bf16_t* A; const bf16_t* Bt; int M, N, K; };

struct StaticOrder {
    int nM, nN, nwg, G, c;
    __host__ __device__ void init(int M, int N, int G_, int c_) { nM = M / BM; nN = N / BM; nwg = nM * nN; G = G_; c = c_; }
    __host__ __device__ bool next(int i, Unit& u) const {
        const long L = (long)i * G + c; if (L >= nwg) return false;
        int wgid = (int)L; { const int q = nwg / NXCD, r = nwg % NXCD, xcd = wgid % NXCD, off = wgid / NXCD; wgid = (xcd < r ? xcd * (q + 1) : r * (q + 1) + (xcd - r) * q) + off; }
        const int nig = WGM * nN, gid = wgid / nig, fm = gid * WGM, gsz = (nM - fm) < WGM ? (nM - fm) : WGM;
        u.pm = fm + ((wgid % nig) % gsz); u.pn = (wgid % nig) / gsz; return true;
    }
    __device__ __forceinline__ void a_ready(const Unit&) const {}
    __device__ __forceinline__ void done(const Unit&) const {}
};

__device__ __forceinline__ unsigned cvt_pk_bf16(float lo, float hi) { unsigned r; asm volatile("v_cvt_pk_bf16_f32 %0, %1, %2" : "=v"(r) : "v"(lo), "v"(hi)); return r; }
typedef float f32x2 __attribute__((ext_vector_type(2)));
__device__ __forceinline__ f32x2 gelu_pk(f32x2 v) {
    const f32x2 av = __builtin_elementwise_abs(v), d = av * 0.2316418882f + 1.0f;
    f32x2 t; t.x = __builtin_amdgcn_rcpf(d.x); t.y = __builtin_amdgcn_rcpf(d.y);
    f32x2 q = t * 0.5307027145f + (-0.7265760135f); q = q * t + 0.7107068705f; q = q * t + (-0.142248368f); q = q * t + 0.127414796f; q = q * t;
    const f32x2 s = (v * v) * (-0.72134752044f);
    f32x2 e; e.x = __builtin_amdgcn_exp2f(s.x); e.y = __builtin_amdgcn_exp2f(s.y);
    const f32x2 m = v * (q * e), r = v - m;
    f32x2 o; o.x = v.x < 0.f ? m.x : r.x; o.y = v.y < 0.f ? m.y : r.y; return o;
}

template <int ACT  > struct EpiBf16 {
    static constexpr bool PERM = true, AFTER_DRAIN = false; static_assert(ACT == 0 || ACT == 1, "EpiBf16: ACT is 0 (none) or 1 (gelu_pk)");
    bf16_t* O; int ldc; const float* bias; int split_cols; size_t split_stride; float scale0;
    __device__ __forceinline__ void operator()(const f32x4 (&acc)[2][2][4][2], const Unit& u, int wr, int wc, int fr, int fq) const {
        const int row0 = u.pm * BM + wr * 64 + fr; int colt = u.pn * BM; bf16_t* base = O;
        float sc = 1.f; if (split_cols) { const int t = colt / split_cols; base += (size_t)t * split_stride; colt -= t * split_cols; if (t == 0) sc = scale0; }
        const int col0 = colt + wc * 32 + 8 * fq, bcol0 = u.pn * BM + wc * 32 + 8 * fq;
        f32x4 bv[2][2];
#pragma unroll
        for (int bj = 0; bj < 2; ++bj)
#pragma unroll
            for (int n = 0; n < 2; ++n) bv[bj][n] = bias ? *(const f32x4*)(bias + bcol0 + bj * HALF + 4 * n) : (f32x4){0.f, 0.f, 0.f, 0.f};
#pragma unroll
        for (int ai = 0; ai < 2; ++ai)
#pragma unroll
            for (int m = 0; m < 4; ++m) { bf16_t* rowp = base + (size_t)(row0 + ai * HALF + m * 16) * ldc + col0;
#pragma unroll
                for (int bj = 0; bj < 2; ++bj) { f32x4 v0 = acc[ai][bj][m][0] + bv[bj][0], v1 = acc[ai][bj][m][1] + bv[bj][1];
                    if (ACT == 1) { f32x2 a = gelu_pk((f32x2){v0[0], v0[1]}), b = gelu_pk((f32x2){v0[2], v0[3]}), c = gelu_pk((f32x2){v1[0], v1[1]}), d = gelu_pk((f32x2){v1[2], v1[3]});
                        v0 = (f32x4){a.x, a.y, b.x, b.y}; v1 = (f32x4){c.x, c.y, d.x, d.y}; }
                    v0 = v0 * sc; v1 = v1 * sc; u32x4 w; w.x = cvt_pk_bf16(v0[0], v0[1]); w.y = cvt_pk_bf16(v0[2], v0[3]); w.z = cvt_pk_bf16(v1[0], v1[1]); w.w = cvt_pk_bf16(v1[2], v1[3]);
                    *(u32x4*)(rowp + bj * HALF) = w; } }
    }
};

template <class Epi, class Sched, bool ALIGN_EPI = false, bool SP2 = false>
__device__ __forceinline__ void gemm_phase(PG8_LAS unsigned char* lds, const Gemm g, const Sched& S, const Epi& E) {
    const int tid = opq_v((int)threadIdx.x), wid = __builtin_amdgcn_readfirstlane(tid >> 6), lane = tid & 63, wr = wid >> 2, wc = wid & 3, fr = lane & 15, fq = lane >> 4;
    const int K = g.K, nt = K / BK;
    unsigned voffA[2], voffB[2];
#pragma unroll
    for (int i = 0; i < 2; ++i) { int R, C; stage_rc(tid * 16 + i * 8192, R, C); const int Rb = Epi::PERM ? ((R & ~31) + perm32(R & 31)) : R;
        voffA[i] = (unsigned)(R * K + C) * 2u; voffB[i] = (unsigned)(Rb * K + C) * 2u; }
    const size_t kstep = (size_t)(BK * 2);
    const size_t hstep = (size_t)HALF * K * 2;
    const size_t tstep = 2 * hstep;
    const unsigned ldsw = (unsigned)wid * 1024u;
    const int aoff = lds_byte(wr * 64 + fr, fq * 8), boff = lds_byte(wc * 32 + fr, fq * 8);
#define PG8_SA(b, h) (((b) * 2 + (h)) * HTB)
#define PG8_SB(b, h) ((4 + (b) * 2 + (h)) * HTB)
#define PG8_STAGE(bufoff, gbase, voff) do { _Pragma("unroll") for (int _i = 0; _i < 2; ++_i) \
        __builtin_amdgcn_global_load_lds((const unsigned*)((const char*)(gbase) + (voff)[_i]), (PG8_LAS unsigned*)(lds + (bufoff) + ldsw + _i * 8192), 16, 0, 0); } while (0)
#define PG8_LDA(dst, b, h) do { _Pragma("unroll") for (int m = 0; m < 4; ++m) _Pragma("unroll") for (int k = 0; k < 2; ++k) dst[m][k] = *(const PG8_LAS bf16x8*)(lds + PG8_SA(b, h) + aoff + m * 2048 + k * 1024); } while (0)
#define PG8_LDB(dst, b, h) do { _Pragma("unroll") for (int n = 0; n < 2; ++n) _Pragma("unroll") for (int k = 0; k < 2; ++k) dst[n][k] = *(const PG8_LAS bf16x8*)(lds + PG8_SB(b, h) + boff + n * 2048 + k * 1024); } while (0)
#define PG8_MMA(ai, bj, At, Bt) do { __builtin_amdgcn_s_setprio(1); _Pragma("unroll") for (int m = 0; m < 4; ++m) _Pragma("unroll") for (int n = 0; n < 2; ++n) _Pragma("unroll") for (int k = 0; k < 2; ++k) \
        acc[ai][bj][m][n] = __builtin_amdgcn_mfma_f32_16x16x32_bf16(Bt[n][k], At[m][k], acc[ai][bj][m][n], 0, 0, 0); __builtin_amdgcn_s_setprio(0); } while (0)
#define PG8_WAIT_V(n) asm volatile("s_waitcnt vmcnt(" #n ")" ::: "memory")
#define PG8_WAIT_L(n) asm volatile("s_waitcnt lgkmcnt(" #n ")" ::: "memory")
#define PG8_BAR __builtin_amdgcn_s_barrier()
#define PG8_SCHED __builtin_amdgcn_sched_barrier(0)
    Unit cur, nxt; int ui = 0;
    if (!S.next(0, cur)) return;
    f32x4 acc[2][2][4][2];
#pragma unroll
    for (int a = 0; a < 2; ++a)
#pragma unroll
        for (int b = 0; b < 2; ++b)
#pragma unroll
            for (int m = 0; m < 4; ++m)
#pragma unroll
                for (int n = 0; n < 2; ++n) acc[a][b][m][n] = (f32x4){0.f, 0.f, 0.f, 0.f};
    bf16x8 At[4][2], B0[2][2], B1[2][2];
    const char* cA = (const char*)g.A + (size_t)cur.pm * tstep; const char* cB = (const char*)g.Bt + (size_t)cur.pn * tstep;
    S.a_ready(cur);
    if constexpr (SP2) {
        PG8_STAGE(PG8_SB(0, 0), cB, voffB); PG8_STAGE(PG8_SB(0, 1), cB + hstep, voffB); PG8_STAGE(PG8_SA(0, 0), cA, voffA); PG8_STAGE(PG8_SA(0, 1), cA + hstep, voffA);
        if (wr == 1) PG8_BAR;
        PG8_WAIT_V(2); PG8_BAR;
        PG8_STAGE(PG8_SB(1, 0), cB + kstep, voffB); PG8_STAGE(PG8_SA(1, 0), cA + kstep, voffA); PG8_STAGE(PG8_SB(1, 1), cB + hstep + kstep, voffB);
        PG8_WAIT_V(6); PG8_BAR;
    } else {
        PG8_STAGE(PG8_SB(0, 0), cB, voffB); PG8_STAGE(PG8_SA(0, 0), cA, voffA); PG8_STAGE(PG8_SB(0, 1), cB + hstep, voffB); PG8_STAGE(PG8_SA(0, 1), cA + hstep, voffA);
        if (wr == 1) PG8_BAR;
        PG8_WAIT_V(4); PG8_BAR;
        PG8_STAGE(PG8_SB(1, 0), cB + kstep, voffB); PG8_STAGE(PG8_SA(1, 0), cA + kstep, voffA); PG8_STAGE(PG8_SB(1, 1), cB + hstep + kstep, voffB);
        PG8_WAIT_V(6); PG8_BAR;
    }
    for (;;) {
        const bool has_next = S.next(ui + 1, nxt);
        const char* nA = has_next ? (const char*)g.A + (size_t)nxt.pm * tstep : cA; const char* nB = has_next ? (const char*)g.Bt + (size_t)nxt.pn * tstep : cB;
        for (int t = 0; t < nt; t += 2) {
            const bool last = (t == nt - 2);
            const char* a1 = cA + (size_t)(t + 1) * kstep;
            const char* a2 = last ? nA : cA + (size_t)(t + 2) * kstep; const char* b2 = last ? nB : cB + (size_t)(t + 2) * kstep;
            const char* a3 = a2 + kstep; const char* b3 = b2 + kstep;
            if (last && has_next) S.a_ready(nxt);
            if constexpr (SP2) {
            PG8_LDB(B0, 0, 0); PG8_LDB(B1, 0, 1); PG8_SCHED; PG8_LDA(At, 0, 0); PG8_STAGE(PG8_SA(1, 1), a1 + hstep, voffA);
            PG8_WAIT_V(8); PG8_WAIT_L(0); PG8_BAR; PG8_MMA(0, 0, At, B0); PG8_MMA(0, 1, At, B1); PG8_BAR; PG8_SCHED;
            PG8_LDA(At, 0, 1); PG8_STAGE(PG8_SB(0, 0), b2, voffB); PG8_STAGE(PG8_SB(0, 1), b2 + hstep, voffB); PG8_STAGE(PG8_SA(0, 0), a2, voffA);
            PG8_WAIT_V(8); PG8_WAIT_L(0); PG8_BAR; PG8_MMA(1, 0, At, B0); PG8_MMA(1, 1, At, B1); PG8_BAR; PG8_SCHED;
            PG8_LDB(B0, 1, 0); PG8_LDB(B1, 1, 1); PG8_SCHED; PG8_LDA(At, 1, 0); PG8_STAGE(PG8_SA(0, 1), a2 + hstep, voffA);
            PG8_WAIT_V(8); PG8_WAIT_L(0); PG8_BAR; PG8_MMA(0, 0, At, B0); PG8_MMA(0, 1, At, B1); PG8_BAR; PG8_SCHED;
            PG8_LDA(At, 1, 1); PG8_STAGE(PG8_SB(1, 0), b3, voffB); PG8_STAGE(PG8_SB(1, 1), b3 + hstep, voffB); PG8_STAGE(PG8_SA(1, 0), a3, voffA);
            PG8_WAIT_V(8); PG8_WAIT_L(0); PG8_BAR; PG8_MMA(1, 0, At, B0); PG8_MMA(1, 1, At, B1); PG8_BAR; PG8_SCHED;
            } else {
            PG8_LDB(B0, 0, 0); PG8_SCHED; PG8_LDA(At, 0, 0); PG8_STAGE(PG8_SA(1, 1), a1 + hstep, voffA);
            PG8_WAIT_L(8); PG8_BAR; PG8_WAIT_L(0); PG8_MMA(0, 0, At, B0); PG8_BAR; PG8_SCHED;
            PG8_LDB(B1, 0, 1); PG8_STAGE(PG8_SB(0, 0), b2, voffB);
            PG8_BAR; PG8_WAIT_L(0); PG8_MMA(0, 1, At, B1); PG8_BAR;
            PG8_LDA(At, 0, 1); PG8_STAGE(PG8_SA(0, 0), a2, voffA);
            PG8_BAR; PG8_WAIT_L(0); PG8_MMA(1, 0, At, B0); PG8_BAR; PG8_SCHED;
            PG8_STAGE(PG8_SB(0, 1), b2 + hstep, voffB);
            PG8_WAIT_V(6); PG8_BAR; PG8_MMA(1, 1, At, B1); PG8_BAR;
            PG8_LDB(B0, 1, 0); PG8_SCHED; PG8_LDA(At, 1, 0); PG8_STAGE(PG8_SA(0, 1), a2 + hstep, voffA);
            PG8_WAIT_L(8); PG8_BAR; PG8_WAIT_L(0); PG8_MMA(0, 0, At, B0); PG8_BAR; PG8_SCHED;
            PG8_LDB(B1, 1, 1); PG8_STAGE(PG8_SB(1, 0), b3, voffB);
            PG8_BAR; PG8_WAIT_L(0); PG8_MMA(0, 1, At, B1); PG8_BAR;
            PG8_LDA(At, 1, 1); PG8_STAGE(PG8_SA(1, 0), a3, voffA);
            PG8_BAR; PG8_WAIT_L(0); PG8_MMA(1, 0, At, B0); PG8_BAR; PG8_SCHED;
            PG8_STAGE(PG8_SB(1, 1), b3 + hstep, voffB);
            PG8_WAIT_V(6); PG8_BAR; PG8_MMA(1, 1, At, B1); PG8_BAR;
            }
        }
        if constexpr (ALIGN_EPI) { if (wr == 0) PG8_BAR; }
        if constexpr (!Epi::AFTER_DRAIN) { E(acc, cur, wr, wc, fr, fq); S.done(cur); }
        if (!has_next) break;
#pragma unroll
        for (int a = 0; a < 2; ++a)
#pragma unroll
            for (int b = 0; b < 2; ++b)
#pragma unroll
                for (int m = 0; m < 4; ++m)
#pragma unroll
                    for (int n = 0; n < 2; ++n) acc[a][b][m][n] = (f32x4){0.f, 0.f, 0.f, 0.f};
        cur = nxt; cA = nA; cB = nB; ++ui;
        if constexpr (ALIGN_EPI) { if (wr == 1) PG8_BAR; }
    }
    PG8_WAIT_V(0);
    if constexpr (!ALIGN_EPI) { if (wr == 0) PG8_BAR; }
    PG8_BAR;
    if constexpr (Epi::AFTER_DRAIN) { E.fused(acc, cur, wr, wc, fr, fq, lds, wid, lane); S.done(cur); }
#undef PG8_SA
#undef PG8_SB
#undef PG8_STAGE
#undef PG8_LDA
#undef PG8_LDB
#undef PG8_MMA
#undef PG8_WAIT_V
#undef PG8_WAIT_L
#undef PG8_BAR
#undef PG8_SCHED
}
}

#define PHASE_IDS const int tx = opq_v((int)threadIdx.x); const int bx = opq_s((int)blockIdx.x); const int gx = opq_s((int)gridDim.x); (void)tx; (void)bx; (void)gx;
#define GRID_LOOP(idx, N) for (long idx = (long)bx * 512 + tx; idx < (long)(N); idx += (long)gx * 512)

namespace pg8 {
__device__ __forceinline__ float sigm(float x) { return __builtin_amdgcn_rcpf(1.f + __expf(-x)); }
struct EpiMerge {
    static constexpr bool PERM = false, AFTER_DRAIN = false;
    float* mf; unsigned short* mb; const unsigned short* u; int which; int mode;
    __device__ __forceinline__ void operator()(const f32x4 (&acc)[2][2][4][2], const Unit& un, int wr, int wc, int fr, int fq) const {
        const int row0 = un.pm * BM + wr * 64 + fr, col0 = un.pn * BM + wc * 32 + 4 * fq;
#pragma unroll
        for (int ai = 0; ai < 2; ++ai)
#pragma unroll
            for (int m = 0; m < 4; ++m) { const size_t r = (size_t)(row0 + ai * HALF + m * 16);
#pragma unroll
                for (int bj = 0; bj < 2; ++bj)
#pragma unroll
                    for (int n = 0; n < 2; ++n) { const int c = col0 + bj * HALF + n * 16;
                        const uint2 gw = *(const uint2*)(u + r * 5120 + 2048 + which * 1024 + c);
                        f32x4 g; g[0] = __uint_as_float(gw.x << 16); g[1] = __uint_as_float(gw.x & 0xffff0000u); g[2] = __uint_as_float(gw.y << 16); g[3] = __uint_as_float(gw.y & 0xffff0000u);
                        f32x4 v = g * acc[ai][bj][m][n];
                        float* p = mf + r * 1024 + c;
                        if (mode >= 1) v = v + *(const f32x4*)p;
                        if (mode < 2) *(f32x4*)p = v;
                        else { uint2 w; w.x = cvt_pk_bf16(v[0], v[1]); w.y = cvt_pk_bf16(v[2], v[3]); *(uint2*)(mb + r * 1024 + c) = w; } } }
    }
};
__device__ __forceinline__ float gelu_sig(float x) { return x * sigm(1.5957691216057308f * (x + 0.044715f * x * x * x)); }
struct EpiG1a {
    static constexpr bool PERM = true, AFTER_DRAIN = false;
    unsigned short* uT; unsigned short* btc; unsigned short* btl;
    __device__ __forceinline__ void operator()(const f32x4 (&acc)[2][2][4][2], const Unit& un, int wr, int wc, int fr, int fq) const {
        const int row0 = un.pm * BM + wr * 64 + fr, col0 = wc * 32 + 8 * fq, pn = un.pn;
#pragma unroll
        for (int ai = 0; ai < 2; ++ai)
#pragma unroll
            for (int m = 0; m < 4; ++m) { const int row = row0 + ai * HALF + m * 16;
                unsigned short* base;
                if (un.pm < 6) base = uT + (size_t)row * 8192 + pn * 256;
                else { const int rr = row - 1536, part = rr >> 9, j = rr & 511;
                    if (pn < 16) base = btc + ((size_t)(pn * 512 + j) * 512 + part * 256);
                    else base = btl + ((size_t)(((pn - 16) >> 2) * 512 + j) * 2048 + part * 1024 + ((pn - 16) & 3) * 256); }
#pragma unroll
                for (int bj = 0; bj < 2; ++bj) { const f32x4 v0 = acc[ai][bj][m][0], v1 = acc[ai][bj][m][1];
                    u32x4 w; w.x = cvt_pk_bf16(v0[0], v0[1]); w.y = cvt_pk_bf16(v0[2], v0[3]); w.z = cvt_pk_bf16(v1[0], v1[1]); w.w = cvt_pk_bf16(v1[2], v1[3]);
                    *(u32x4*)(base + bj * HALF + col0) = w; } }
    }
};
struct EpiG1b {
    static constexpr bool PERM = true, AFTER_DRAIN = false;
    unsigned short* u2; int pad0; int pad1;
    __device__ __forceinline__ void operator()(const f32x4 (&acc)[2][2][4][2], const Unit& un, int wr, int wc, int fr, int fq) const {
        const int row0 = un.pm * BM + wr * 64 + fr, col0 = un.pn * BM + wc * 32 + 8 * fq;
        const int act = un.pn < 4 ? 0 : (un.pn < 8 ? 1 : 2);
#pragma unroll
        for (int ai = 0; ai < 2; ++ai)
#pragma unroll
            for (int m = 0; m < 4; ++m) { unsigned short* rowp = u2 + (size_t)(row0 + ai * HALF + m * 16) * 5120 + col0;
#pragma unroll
                for (int bj = 0; bj < 2; ++bj) { f32x4 v0 = acc[ai][bj][m][0], v1 = acc[ai][bj][m][1];
                    if (act == 1) { _Pragma("unroll") for (int e = 0; e < 4; ++e) { v0[e] = gelu_sig(v0[e]); v1[e] = gelu_sig(v1[e]); } }
                    else if (act == 2) { _Pragma("unroll") for (int e = 0; e < 4; ++e) { v0[e] = sigm(v0[e]); v1[e] = sigm(v1[e]); } }
                    u32x4 w; w.x = cvt_pk_bf16(v0[0], v0[1]); w.y = cvt_pk_bf16(v0[2], v0[3]); w.z = cvt_pk_bf16(v1[0], v1[1]); w.w = cvt_pk_bf16(v1[2], v1[3]);
                    *(u32x4*)(rowp + bj * HALF) = w; } }
    }
};
struct EpiFnet {
    static constexpr bool PERM = true, AFTER_DRAIN = false;
    unsigned short* zfn; int L; int tok0;
    __device__ __forceinline__ void operator()(const f32x4 (&acc)[2][2][4][2], const Unit& un, int wr, int wc, int fr, int fq) const {
        const int b = un.pn >> 1, jb = (un.pn & 1) * 256;
        const int row0 = tok0 + b * L + un.pm * BM + wr * 64 + fr, col0 = jb + wc * 32 + 8 * fq;
#pragma unroll
        for (int ai = 0; ai < 2; ++ai)
#pragma unroll
            for (int m = 0; m < 4; ++m) { unsigned short* rowp = zfn + (size_t)(row0 + ai * HALF + m * 16) * 512 + col0;
#pragma unroll
                for (int bj = 0; bj < 2; ++bj) { const f32x4 v0 = acc[ai][bj][m][0], v1 = acc[ai][bj][m][1];
                    u32x4 w; w.x = cvt_pk_bf16(v0[0], v0[1]); w.y = cvt_pk_bf16(v0[2], v0[3]); w.z = cvt_pk_bf16(v1[0], v1[1]); w.w = cvt_pk_bf16(v1[2], v1[3]);
                    *(u32x4*)(rowp + bj * HALF) = w; } }
    }
};
struct EpiResid {
    static constexpr bool PERM = false, AFTER_DRAIN = false;
    const float* xin; float* x; const float* gvec; int gstride; int pad;
    __device__ __forceinline__ void operator()(const f32x4 (&acc)[2][2][4][2], const Unit& un, int wr, int wc, int fr, int fq) const {
        const int row0 = un.pm * BM + wr * 64 + fr, col0 = un.pn * BM + wc * 32 + 4 * fq;
        const int grp = un.pm < 16 ? 0 : 1 + ((un.pm - 16) >> 2);
        f32x4 gv[2][2];
#pragma unroll
        for (int bj = 0; bj < 2; ++bj)
#pragma unroll
            for (int n = 0; n < 2; ++n) gv[bj][n] = *(const f32x4*)(gvec + (size_t)grp * gstride + col0 + bj * HALF + n * 16);
#pragma unroll
        for (int ai = 0; ai < 2; ++ai)
#pragma unroll
            for (int m = 0; m < 4; ++m) { const size_t ro = (size_t)(row0 + ai * HALF + m * 16) * 1024 + col0;
#pragma unroll
                for (int bj = 0; bj < 2; ++bj)
#pragma unroll
                    for (int n = 0; n < 2; ++n) { const size_t o = ro + bj * HALF + n * 16; *(f32x4*)(x + o) = *(const f32x4*)(xin + o) + gv[bj][n] * acc[ai][bj][m][n]; } }
    }
};
struct EpiSwiglu {
    static constexpr bool PERM = true, AFTER_DRAIN = false;
    unsigned short* hm; int ld; int pad;
    __device__ __forceinline__ void operator()(const f32x4 (&acc)[2][2][4][2], const Unit& un, int wr, int wc, int fr, int fq) const {
        const int row0 = un.pm * BM + wr * 64 + fr, col0 = un.pn * HALF + wc * 32 + 8 * fq;
#pragma unroll
        for (int ai = 0; ai < 2; ++ai)
#pragma unroll
            for (int m = 0; m < 4; ++m) {
                f32x4 o0, o1;
#pragma unroll
                for (int e = 0; e < 4; ++e) { const float g0 = acc[ai][0][m][0][e], g1 = acc[ai][0][m][1][e];
                    o0[e] = g0 * sigm(g0) * acc[ai][1][m][0][e]; o1[e] = g1 * sigm(g1) * acc[ai][1][m][1][e]; }
                u32x4 w; w.x = cvt_pk_bf16(o0[0], o0[1]); w.y = cvt_pk_bf16(o0[2], o0[3]); w.z = cvt_pk_bf16(o1[0], o1[1]); w.w = cvt_pk_bf16(o1[2], o1[3]);
                *(u32x4*)(hm + (size_t)(row0 + ai * HALF + m * 16) * ld + col0) = w; }
    }
};
}
#define LAS __attribute__((address_space(3)))
typedef unsigned v4u __attribute__((ext_vector_type(4)));
__device__ __forceinline__ unsigned pk2(float lo, float hi) { return (unsigned)f2bf(lo) | ((unsigned)f2bf(hi) << 16); }
__device__ __forceinline__ void transpose_item(const float* __restrict__ W, int K, int N, bf16_t* __restrict__ WT, int orow0, int k0, int n0, LAS float* scr, int lane) {
#pragma unroll 8
    for (int i = 0; i < 32; ++i) { const int kk = 2 * i + (lane >> 5); scr[kk * 33 + (lane & 31)] = W[(size_t)(k0 + kk) * N + n0 + (lane & 31)]; }
    asm volatile("s_waitcnt lgkmcnt(0)" ::: "memory");
    const int c = lane & 7;
#pragma unroll
    for (int j = 0; j < 4; ++j) { const int n = (lane >> 3) + 8 * j; const LAS float* s = scr + (8 * c) * 33 + n;
        v4u o; o.x = pk2(s[0 * 33], s[1 * 33]); o.y = pk2(s[2 * 33], s[3 * 33]); o.z = pk2(s[4 * 33], s[5 * 33]); o.w = pk2(s[6 * 33], s[7 * 33]);
        *(v4u*)(WT + (size_t)(orow0 + n) * K + k0 + 8 * c) = o; }
    asm volatile("s_waitcnt lgkmcnt(0)" ::: "memory");
}
struct LayerW { bf16_t *win, *wa, *wb, *wc, *wo, *wgu, *wd; };
__device__ __forceinline__ void d_convert(unsigned char* lds, const float* w_in, const float* w_a, const float* w_b, const float* w_c, const float* w_o, const float* w_gu, const float* w_down, const LayerW& o) {
    PHASE_IDS
    const int wave = tx >> 6, lane = tx & 63;
    LAS float* scr = (LAS float*)((LAS unsigned char*)lds + wave * 8448);
    constexpr int I_IN = 16 * 224, I_A = 8 * 32, I_C = 16 * 32, I_GU = 16 * 176, I_D = 44 * 32;
    constexpr int NITEMS = I_IN + 2 * I_A + 2 * I_C + I_GU + I_D;
    for (int it = bx * 8 + wave; it < NITEMS; it += gx * 8) {
        int r = it;
        if (r < I_IN) { const int kb = r / 224, nb = r % 224; const int n0 = nb * 32;
            if (n0 >= 1536 && n0 < 2048) continue;
            transpose_item(w_in, D, DIN, o.win, n0 < 1536 ? n0 : n0 + 512, kb * 64, n0, scr, lane); continue; } r -= I_IN;
        if (r < I_A) { const int kb = r / 32, nb = r % 32; transpose_item(w_a, 512, D, o.wa, nb * 32, kb * 64, nb * 32, scr, lane); continue; } r -= I_A;
        if (r < I_A) { const int kb = r / 32, nb = r % 32; transpose_item(w_b, 512, D, o.wb, nb * 32, kb * 64, nb * 32, scr, lane); continue; } r -= I_A;
        if (r < I_C) { const int kb = r / 32, nb = r % 32; transpose_item(w_c, D, D, o.wc, nb * 32, kb * 64, nb * 32, scr, lane); continue; } r -= I_C;
        if (r < I_C) { const int kb = r / 32, nb = r % 32; transpose_item(w_o, D, D, o.wo, nb * 32, kb * 64, nb * 32, scr, lane); continue; } r -= I_C;
        if (r < I_GU) { const int kb = r / 176, nb = r % 176; const int n0 = nb * 32;
            const int orow = n0 < DFF ? (n0 >> 7) * 256 + (n0 & 127) : ((n0 - DFF) >> 7) * 256 + 128 + ((n0 - DFF) & 127);
            transpose_item(w_gu, D, 2 * DFF, o.wgu, orow, kb * 64, n0, scr, lane); continue; } r -= I_GU;
        { const int kb = r / 32, nb = r % 32; transpose_item(w_down, DFF, D, o.wd, nb * 32, kb * 64, nb * 32, scr, lane); }
    }
}

typedef float f32x4v __attribute__((ext_vector_type(4)));
__device__ __forceinline__ void d_fold_fnet(unsigned char* lds_, const float* __restrict__ w_in, bf16_t* __restrict__ winT) {
    PHASE_IDS
    float* WT = (float*)lds_;
    float* TAB = (float*)(lds_ + 64 * 129 * 4);
    const int lane = tx & 63, wave = tx >> 6, r16 = lane & 15, quad = lane >> 4;
    for (int item = gx - 1 - bx; item < 64; item += gx) {
        const int kb = item >> 2, g = item & 3, k0 = kb * 64;
        __syncthreads();
        if (tx < 128) { float sn, cs; sincospif((float)tx * (2.0f / 128.0f), &sn, &cs); TAB[tx] = cs; TAB[128 + tx] = sn; }
        for (int e = tx; e < 64 * 128; e += 512) { const int kk = e >> 7, cc = e & 127; WT[kk * 129 + cc] = w_in[(size_t)(k0 + kk) * DIN + OFF_FN + g * 128 + cc]; }
        __syncthreads();
#pragma unroll 1
        for (int mi = 0; mi < 2; ++mi) { const int mt = wave * 2 + mi, part = mt >> 3, c0 = (mt & 7) * 16;
            f32x4v acc[4];
#pragma unroll
            for (int nt = 0; nt < 4; ++nt) acc[nt] = (f32x4v){0.f, 0.f, 0.f, 0.f};
            for (int kk0 = 0; kk0 < 128; kk0 += 4) { const int cp = kk0 + quad;
                const float a = TAB[part * 128 + (((c0 + r16) * cp) & 127)];
#pragma unroll
                for (int nt = 0; nt < 4; ++nt) acc[nt] = __builtin_amdgcn_mfma_f32_16x16x4f32(a, WT[(nt * 16 + r16) * 129 + cp], acc[nt], 0, 0, 0); }
#pragma unroll
            for (int nt = 0; nt < 4; ++nt)
#pragma unroll
                for (int j = 0; j < 4; ++j) winT[(size_t)(1536 + part * 512 + g * 128 + c0 + quad * 4 + j) * D + k0 + nt * 16 + r16] = f2bf(acc[nt][j]);
        }
    }
    __syncthreads();
}
__device__ __forceinline__ void d_dftmat(bf16_t* __restrict__ dc, bf16_t* __restrict__ dl) {
    PHASE_IDS
    GRID_LOOP(idx, 256 * 512) { const int lp = (int)(idx >> 9), col = (int)(idx & 511), part = col >> 8, l = col & 255; float sn, cs; sincospif((float)((l * lp) & 255) * (2.0f / 256.0f), &sn, &cs);
        dc[idx] = f2bf((part ? -sn : cs) * 0.005524271728019903f); }
    GRID_LOOP(idx, 1024 * 2048) { const int lp = (int)(idx >> 11), col = (int)(idx & 2047), part = col >> 10, l = col & 1023; float sn, cs; sincospif((float)((l * lp) & 1023) * (2.0f / 1024.0f), &sn, &cs);
        dl[idx] = f2bf((part ? -sn : cs) * 0.0027621358640099515f); }
}
__device__ __forceinline__ void d_mod(unsigned char* lds_, const float* __restrict__ c, const float* __restrict__ c_ctx, const float* __restrict__ w_ada, const float* __restrict__ b_ada, float* __restrict__ mod) {
    PHASE_IDS
    float* SC = (float*)lds_;
    float* RED = (float*)(lds_ + 20480);
    const int lane = tx & 63, wave = tx >> 6;
    for (int e = tx; e < 5 * 1024; e += 512) { const int g = e >> 10, k = e & 1023; SC[e] = siluf_(g == 0 ? c_ctx[k] : c[(g - 1) * D + k]); }
    __syncthreads();
    for (int item = bx; item < DEPTH * 24; item += gx) {
        const int l = item / 24, n0 = (item % 24) * 256;
        float4 acc[5];
#pragma unroll
        for (int g = 0; g < 5; ++g) acc[g] = make_float4(0.f, 0.f, 0.f, 0.f);
        const float* wp = w_ada + ((size_t)l * D + wave * 128) * NMOD + n0 + lane * 4;
#pragma unroll 8
        for (int k = 0; k < 128; ++k) { const float4 w = *(const float4*)(wp + (size_t)k * NMOD);
#pragma unroll
            for (int g = 0; g < 5; ++g) { const float sv = SC[g * 1024 + wave * 128 + k]; acc[g].x += sv * w.x; acc[g].y += sv * w.y; acc[g].z += sv * w.z; acc[g].w += sv * w.w; } }
#pragma unroll
        for (int g = 0; g < 5; ++g) *(float4*)&RED[(wave * 5 + g) * 256 + lane * 4] = acc[g];
        __syncthreads();
        for (int e = tx; e < 5 * 256; e += 512) { const int g = e >> 8, n = e & 255; float sum = b_ada[l * NMOD + n0 + n];
#pragma unroll
            for (int w = 0; w < 8; ++w) sum += RED[(w * 5 + g) * 256 + n];
            mod[((size_t)l * 5 + g) * NMOD + n0 + n] = sum; }
        __syncthreads();
    }
}

__device__ __forceinline__ void d_filt_h2(float* lds, const float* __restrict__ fw1, const float* __restrict__ fb1, const float* __restrict__ fw2, const float* __restrict__ fb2, const float* __restrict__ ffreq, float* __restrict__ h2) {
    PHASE_IDS
    const int wave = tx >> 6, j = tx & 63;
    float* feats = lds + wave * 96; float* h1 = feats + 32;
    const int nw = gx * 8;
    for (int base = 0; base < 1280; base += nw) {
        const int r = base + bx * 8 + wave; const bool valid = r < 1280;
        const int L = r < 256 ? 256 : 1024; const int ti = r < 256 ? r : r - 256;
        const float t = (float)ti / (float)L;
        if (valid && j < 17) {
            float f;
            if (j == 0) f = t;
            else if (j <= 8) f = sinf(6.283185307179586f * t * (float)j);
            else f = cosf(6.283185307179586f * t * (float)(j - 8));
            feats[j] = f;
        }
        __syncthreads();
        if (valid) { float a = fb1[j]; for (int k = 0; k < 17; ++k) a += feats[k] * fw1[k * 64 + j]; h1[j] = sinf(ffreq[j] * a); }
        __syncthreads();
        if (valid) { float b = fb2[j]; for (int k = 0; k < 64; ++k) b += h1[k] * fw2[k * 64 + j]; h2[r * 64 + j] = sinf(ffreq[j] * b); }
        __syncthreads();
    }
}
__device__ __forceinline__ void d_norm(const float* __restrict__ x, const float* __restrict__ gw, const float* __restrict__ modl, int sh_off, int sc_off, bf16_t* __restrict__ h) {
    PHASE_IDS
    const int lane = tx & 63;
    for (int m = bx * 8 + (tx >> 6); m < MTOK; m += gx * 8) {
        const RowInfo ri = rowinfo(m);
        const float* xr = x + (size_t)m * D;
        float s = 0.f;
        for (int i = 0; i < 16; ++i) { const float v = xr[lane + 64 * i]; s += v * v; }
        for (int o = 1; o < 64; o <<= 1) s += __shfl_xor(s, o);
        const float rs = rsqrtf(s * (1.f / D) + EPS);
        const float* mg = modl + ri.grp * NMOD;
        for (int i = 0; i < 16; ++i) { const int k = lane + 64 * i; h[(size_t)m * D + k] = f2bf(xr[k] * rs * gw[k] * (1.f + mg[sc_off + k]) + mg[sh_off + k]); }
    }
}
__device__ __forceinline__ void d_final(const float* __restrict__ x, const float* __restrict__ gw, float* __restrict__ out) {
    PHASE_IDS
    const int lane = tx & 63;
    for (int m = bx * 8 + (tx >> 6); m < MTOK; m += gx * 8) {
        const float* xr = x + (size_t)m * D;
        float s = 0.f;
        for (int i = 0; i < 16; ++i) { const float v = xr[lane + 64 * i]; s += v * v; }
        for (int o = 1; o < 64; o <<= 1) s += __shfl_xor(s, o);
        const float rs = rsqrtf(s * (1.f / D) + EPS);
        for (int i = 0; i < 16; ++i) { const int k = lane + 64 * i; out[(size_t)m * D + k] = xr[k] * rs * gw[k]; }
    }
}

__device__ __forceinline__ void d_filt_h3T(unsigned char* lds_, const float* __restrict__ h2all, const float* __restrict__ fw3all, float* __restrict__ krawTall) {
    PHASE_IDS
    float* FW = (float*)lds_;
    float* HT = (float*)(lds_ + 16384);
    const int jj = (tx & 15) * 4, rr = (tx >> 4) * 4;
    for (int tile = bx; tile < DEPTH * 320; tile += gx) {
        const int l = tile / 320, tj = (tile % 320) / 10, tr = tile % 10, j0 = tj * 64, r0 = tr * 128;
        const float* h2 = h2all + (size_t)l * 1280 * 64; const float* fw3 = fw3all + (size_t)l * 64 * 2048; float* krawT = krawTall + (size_t)l * 2048 * 1280;
        __syncthreads();
        for (int e = tx; e < 4096; e += 512) { const int k = e >> 6, jl = e & 63; FW[e] = fw3[k * 2048 + j0 + jl]; }
        for (int e = tx; e < 2048; e += 512) { const int rl = e >> 4, k4 = e & 15; const float4 v = *(const float4*)(h2 + (size_t)(r0 + rl) * 64 + k4 * 4);
            HT[(k4 * 4 + 0) * 128 + rl] = v.x; HT[(k4 * 4 + 1) * 128 + rl] = v.y; HT[(k4 * 4 + 2) * 128 + rl] = v.z; HT[(k4 * 4 + 3) * 128 + rl] = v.w; }
        __syncthreads();
        float acc[4][4];
#pragma unroll
        for (int a = 0; a < 4; ++a)
#pragma unroll
            for (int b = 0; b < 4; ++b) acc[a][b] = 0.f;
#pragma unroll 8
        for (int k = 0; k < 64; ++k) { const float4 f = *(const float4*)&FW[k * 64 + jj]; const float4 hv = *(const float4*)&HT[k * 128 + rr];
            const float fa[4] = {f.x, f.y, f.z, f.w}, ha[4] = {hv.x, hv.y, hv.z, hv.w};
#pragma unroll
            for (int a = 0; a < 4; ++a)
#pragma unroll
                for (int b = 0; b < 4; ++b) acc[a][b] += fa[a] * ha[b]; }
        float tt[4];
#pragma unroll
        for (int b = 0; b < 4; ++b) { const int r = r0 + rr + b; tt[b] = r < 256 ? (float)r * (1.0f / 256.0f) : (float)(r - 256) * (1.0f / 1024.0f); }
#pragma unroll
        for (int a = 0; a < 4; ++a) { const int j = j0 + jj + a; const float delta = DECAY_SLOW + (DECAY_FAST - DECAY_SLOW) * ((float)(j & 511) / 511.0f);
            float4 o; o.x = acc[a][0] * expf(-tt[0] * delta); o.y = acc[a][1] * expf(-tt[1] * delta); o.z = acc[a][2] * expf(-tt[2] * delta); o.w = acc[a][3] * expf(-tt[3] * delta);
            *(float4*)(krawT + (size_t)j * 1280 + r0 + rr) = o; }
    }
    __syncthreads();
}
constexpr int RT_LAT0 = 2 * 512 * 512, RT_LAYER = RT_LAT0 + 2 * 512 * 2048;
__device__ __forceinline__ void d_filt_build(const float* __restrict__ krawT, bf16_t* __restrict__ rt) {
    PHASE_IDS
    const int lane = tx & 63;
    for (int task = bx * 8 + (tx >> 6); task < 2048; task += gx * 8) {
        const int c = task & 511, o = (task >> 9) & 1, ls = task >> 10;
        const int L = ls ? 1024 : 256, r0 = ls ? 256 : 0;
        const float* fw = krawT + (size_t)(o * 1024 + c) * 1280 + r0;
        const float* bw = krawT + (size_t)(o * 1024 + 512 + c) * 1280 + r0;
        float ss = 0.f;
        for (int t = lane; t < L; t += 64) { const float f = fw[t]; ss += f * f; if (t >= 1) { const float b = bw[t]; ss += b * b; } }
        for (int of = 1; of < 64; of <<= 1) ss += __shfl_xor(ss, of);
        const float sc = rsqrtf(ss + EPS);
        bf16_t* dst = rt + (ls ? RT_LAT0 + (size_t)(o * 512 + c) * 2048 : (size_t)(o * 512 + c) * 512);
        for (int p = lane; p < 2 * L; p += 64) { float v = 0.f; if (p >= 1 && p <= L) v = fw[L - p]; else if (p > L) v = bw[p - L]; dst[p] = f2bf(v * sc); }
    }
}

typedef float f32x16 __attribute__((ext_vector_type(16)));
__device__ __forceinline__ void unpack8(const uint4 v, float* f) {
    f[0] = __uint_as_float(v.x << 16); f[1] = __uint_as_float(v.x & 0xffff0000u); f[2] = __uint_as_float(v.y << 16); f[3] = __uint_as_float(v.y & 0xffff0000u);
    f[4] = __uint_as_float(v.z << 16); f[5] = __uint_as_float(v.z & 0xffff0000u); f[6] = __uint_as_float(v.w << 16); f[7] = __uint_as_float(v.w & 0xffff0000u);
}
template <bool LAT>
__device__ __forceinline__ void hy_unit(unsigned char* lds_, const int tx, const bf16_t* __restrict__ uT, const float* __restrict__ hcw, const float* __restrict__ hcb, const float* __restrict__ hbias,
                                        const bf16_t* __restrict__ rt, const int c0, bf16_t* __restrict__ zhy) {
    constexpr int B = LAT ? 4 : 16, L = LAT ? 1024 : 256, ZPAD = LAT ? 224 : 32, LZ = L + 2 * ZPAD, TOK0 = LAT ? MCTX : 0, ND = LAT ? 78 : 18, CPS = 2 * L + 32;
    bf16_t* CP = (bf16_t*)lds_;
    bf16_t* ZB = (bf16_t*)(lds_ + 66560);
    bf16_t* X1 = (bf16_t*)(lds_ + 66560 + 23552);
    bf16_t* X2 = X1 + 2 * 4096;
    const int lane = tx & 63, wave = tx >> 6, ch = wave >> 2, wq = wave & 3, r = lane & 31, h = lane >> 5;
    __syncthreads();
    { constexpr int PER = 2 * ZPAD / 8, NZ = 2 * B * PER;
      for (int e = tx; e < NZ; e += 512) { const int rowi = e / PER, k = e % PER; const int off = k < ZPAD / 8 ? k * 8 : ZPAD + L + (k - ZPAD / 8) * 8;
          *(uint4*)&ZB[rowi * LZ + off] = make_uint4(0u, 0u, 0u, 0u); } }
#pragma unroll 1
    for (int i = 0; i < 6; ++i) { const int e = tx + 512 * i, cc = e / 1536, rtp = (e >> 9) % 3, chunk = e & 511, tok = chunk * 8, b = tok / L, t = tok % L;
        const int row = rtp * 512 + c0 + cc;
        const bf16_t* src = uT + (size_t)row * 8192 + TOK0 + tok;
        float x[10]; unpack8(*(const uint4*)src, x + 1);
        x[0] = t > 0 ? bf2f(src[-1]) : 0.f; x[9] = t + 8 < L ? bf2f(src[8]) : 0.f;
        const float w0 = hcw[row], w1 = hcw[1536 + row], w2 = hcw[3072 + row], cb = hcb[row];
        float o[8];
#pragma unroll
        for (int j = 0; j < 8; ++j) o[j] = cb + w0 * x[j] + w1 * x[j + 1] + w2 * x[j + 2];
        uint4 pk; pk.x = pk2(o[0], o[1]); pk.y = pk2(o[2], o[3]); pk.z = pk2(o[4], o[5]); pk.w = pk2(o[6], o[7]);
        bf16_t* dst = rtp == 0 ? &ZB[(cc * B + b) * LZ + ZPAD + t] : (rtp == 1 ? &X1[cc * 4096 + tok] : &X2[cc * 4096 + tok]);
        *(uint4*)dst = pk; }
    const float bias0 = hbias[c0 + ch], bias1 = hbias[512 + c0 + ch];
    const int tau = LAT ? 8 * wq + (r >> 2) : 2 * wq + (r >> 4), b = LAT ? (r & 3) : (r & 15);
    const int d16hi = LAT ? 16 * wq + 14 : 4 * wq + 2;
    const bf16_t* pa = CP + (ch * 8 + ((8 - (r & 7)) & 7)) * CPS + (L - 16 * d16hi - ((r + 7) & ~7) + 8 * h);
    const bf16_t* pb = ZB + (ch * B + b) * LZ + ZPAD + 16 * (2 * tau - d16hi) + 8 * h;
    uint2 zpk[4];
#pragma unroll 1
    for (int o = 0; o < 2; ++o) {
        for (int e = tx; e < 2 * (2 * L / 8); e += 512) { const int cc = e / (2 * L / 8), a = e % (2 * L / 8);
            const bf16_t* src = rt + (LAT ? RT_LAT0 + (size_t)(o * 512 + c0 + cc) * 2048 : (size_t)(o * 512 + c0 + cc) * 512) + a * 8;
            const uint4 lo = *(const uint4*)src; const uint4 hi = (a + 1 < 2 * L / 8) ? *(const uint4*)(src + 8) : make_uint4(0u, 0u, 0u, 0u);
            const unsigned w[8] = {lo.x, lo.y, lo.z, lo.w, hi.x, hi.y, hi.z, hi.w};
#pragma unroll
            for (int rho = 0; rho < 8; ++rho) { uint4 q;
                if ((rho & 1) == 0) { q.x = w[rho / 2]; q.y = w[rho / 2 + 1]; q.z = w[rho / 2 + 2]; q.w = w[rho / 2 + 3]; }
                else { const int k = rho / 2; q.x = (w[k] >> 16) | (w[k + 1] << 16); q.y = (w[k + 1] >> 16) | (w[k + 2] << 16); q.z = (w[k + 2] >> 16) | (w[k + 3] << 16); q.w = (w[k + 3] >> 16) | (w[k + 4] << 16); }
                *(uint4*)&CP[(cc * 8 + rho) * CPS + a * 8] = q; } }
        if (o == 0) { for (int e = tx; e < 2 * 8 * 4; e += 512) { const int cr = e >> 2, k = e & 3; *(uint4*)&CP[cr * CPS + 2 * L + k * 8] = make_uint4(0u, 0u, 0u, 0u); } }
        else {
#pragma unroll
            for (int g = 0; g < 4; ++g) *(uint2*)&ZB[(ch * B + b) * LZ + ZPAD + 32 * tau + 8 * g + 4 * h] = zpk[g]; }
        __syncthreads();
        f32x16 acc;
#pragma unroll
        for (int i = 0; i < 16; ++i) acc[i] = 0.f;
#pragma unroll 6
        for (int i = 0; i < ND; ++i) acc = __builtin_amdgcn_mfma_f32_32x32x16_bf16(*(const bf16x8*)(pa + 16 * i), *(const bf16x8*)(pb + 16 * i), acc, 0, 0, 0);
        const bf16_t* gate = (o == 0 ? X1 : X2) + ch * 4096 + b * L;
        const float bias = o == 0 ? bias0 : bias1;
#pragma unroll
        for (int g = 0; g < 4; ++g) { const int t4 = 32 * tau + 8 * g + 4 * h;
            const uint2 zv = *(const uint2*)&ZB[(ch * B + b) * LZ + ZPAD + t4], gv = *(const uint2*)&gate[t4];
            const float z0 = __uint_as_float(zv.x << 16), z1 = __uint_as_float(zv.x & 0xffff0000u), z2 = __uint_as_float(zv.y << 16), z3 = __uint_as_float(zv.y & 0xffff0000u);
            const float g0 = __uint_as_float(gv.x << 16), g1 = __uint_as_float(gv.x & 0xffff0000u), g2 = __uint_as_float(gv.y << 16), g3 = __uint_as_float(gv.y & 0xffff0000u);
            const float r0 = g0 * (acc[4 * g] + bias * z0), r1 = g1 * (acc[4 * g + 1] + bias * z1), r2 = g2 * (acc[4 * g + 2] + bias * z2), r3 = g3 * (acc[4 * g + 3] + bias * z3);
            if (o == 0) { zpk[g].x = pk2(r0, r1); zpk[g].y = pk2(r2, r3); }
            else { bf16_t* dst = zhy + (size_t)(TOK0 + b * L + t4) * 512 + c0 + ch; dst[0] = f2bf(r0); dst[512] = f2bf(r1); dst[1024] = f2bf(r2); dst[1536] = f2bf(r3); } }
        __syncthreads();
    }
}
__device__ __forceinline__ void d_hyena(unsigned char* lds_, const bf16_t* __restrict__ uT, const float* __restrict__ hcw, const float* __restrict__ hcb, const float* __restrict__ hbias, const bf16_t* __restrict__ rt, bf16_t* __restrict__ zhy) {
    PHASE_IDS
    for (int pu = bx; pu < 256; pu += gx) {
        hy_unit<true>(lds_, tx, uT, hcw, hcb, hbias, rt, 2 * pu, zhy);
        hy_unit<false>(lds_, tx, uT, hcw, hcb, hbias, rt, 2 * pu, zhy);
    }
    __syncthreads();
}

__device__ __forceinline__ void d_rg_fast(unsigned char* lds_, const bf16_t* __restrict__ u, const float* __restrict__ cw, const float* __restrict__ cb,
                                          const float* __restrict__ wr, const float* __restrict__ br, const float* __restrict__ wi, const float* __restrict__ bi, const float* __restrict__ lam,
                                          const float* __restrict__ state, int layer, float* __restrict__ hf, bf16_t* __restrict__ zrg, float* __restrict__ new_state) {
    PHASE_IDS
    constexpr int AP = 136;
    bf16_t* ACH = (bf16_t*)lds_;
    float* XR32 = (float*)(lds_ + 34816);
    bf16_t* BT = (bf16_t*)(lds_ + 51200);
    float* AB = (float*)(lds_ + 68608);
    float* SEG = (float*)(lds_ + 101376);
    float* CARRY = (float*)(lds_ + 105472);
    float* CWL = (float*)(lds_ + 105728);
    const int lane = tx & 63, wave = tx >> 6, r16 = lane & 15, quad = lane >> 4;
    const int kg = tx & 15, tr = tx >> 4;
    const int chain = tx & 31, seg = tx >> 5;
    for (int unit = bx; unit < 256; unit += gx) {
        const int s = unit >> 5, n = (unit >> 2) & 7, q = unit & 3;
        const bool isctx = s < 4;
        const int row0 = s * 1024, Ls = isctx ? 256 : 1024, ch0 = n * 128 + q * 32;
        __syncthreads();
        for (int e = tx; e < 640; e += 512) { const int k = e >> 7, cc = e & 127; CWL[e] = k < 4 ? cw[k * 1024 + n * 128 + cc] : cb[n * 128 + cc]; }
        for (int dir = 0; dir < 2; ++dir) {
            __syncthreads();
#pragma unroll 4
            for (int i = 0; i < 16; ++i) { const int e = tx + 512 * i, gate = e >> 12, k = (e >> 5) & 127, c = e & 31;
                const float* W = gate ? wi : wr;
                BT[(gate * 32 + c) * AP + k] = f2bf(W[((size_t)(dir * 8 + n) * 128 + k) * 128 + q * 32 + c]); }
            if (tx < 32) CARRY[tx] = isctx ? 0.f : state[((size_t)((s - 4) * DEPTH + layer) * 2 + dir) * DRG + ch0 + tx];
            __syncthreads();
            float brv[2], biv[2], sp8[2];
#pragma unroll
            for (int h2 = 0; h2 < 2; ++h2) { const int ch = dir * 1024 + ch0 + h2 * 16 + r16; brv[h2] = br[ch]; biv[h2] = bi[ch]; sp8[h2] = 8.0f * log1pf(expf(-lam[ch])); }
            for (int ci = 0; ci < 8; ++ci) {
                const int c = dir ? 7 - ci : ci; const int tbase = row0 + c * 128;
                {
                    const int t0 = tbase + tr * 4;
                    const int seq_lo = row0 + ((t0 - row0) / Ls) * Ls, seq_hi = seq_lo + Ls;
                    float in[7][8];
#pragma unroll
                    for (int j = 0; j < 7; ++j) { const int row = t0 - 2 + j;
                        uint4 v = make_uint4(0u, 0u, 0u, 0u);
                        if (row >= seq_lo && row < seq_hi) v = *(const uint4*)(u + (size_t)row * 5120 + n * 128 + kg * 8);
                        in[j][0] = __uint_as_float(v.x << 16); in[j][1] = __uint_as_float(v.x & 0xffff0000u); in[j][2] = __uint_as_float(v.y << 16); in[j][3] = __uint_as_float(v.y & 0xffff0000u);
                        in[j][4] = __uint_as_float(v.z << 16); in[j][5] = __uint_as_float(v.z & 0xffff0000u); in[j][6] = __uint_as_float(v.w << 16); in[j][7] = __uint_as_float(v.w & 0xffff0000u); }
                    float cwv[4][8], cbv[8];
#pragma unroll
                    for (int k = 0; k < 4; ++k) { const float4 w0 = *(const float4*)&CWL[k * 128 + kg * 8], w1 = *(const float4*)&CWL[k * 128 + kg * 8 + 4];
                        cwv[k][0] = w0.x; cwv[k][1] = w0.y; cwv[k][2] = w0.z; cwv[k][3] = w0.w; cwv[k][4] = w1.x; cwv[k][5] = w1.y; cwv[k][6] = w1.z; cwv[k][7] = w1.w; }
                    { const float4 w0 = *(const float4*)&CWL[512 + kg * 8], w1 = *(const float4*)&CWL[512 + kg * 8 + 4];
                        cbv[0] = w0.x; cbv[1] = w0.y; cbv[2] = w0.z; cbv[3] = w0.w; cbv[4] = w1.x; cbv[5] = w1.y; cbv[6] = w1.z; cbv[7] = w1.w; }
#pragma unroll
                    for (int j = 0; j < 4; ++j) { float o[8];
#pragma unroll
                        for (int e = 0; e < 8; ++e) o[e] = cbv[e] + in[j][e] * cwv[0][e] + in[j + 1][e] * cwv[1][e] + in[j + 2][e] * cwv[2][e] + in[j + 3][e] * cwv[3][e];
                        uint4 pk; pk.x = pk2(o[0], o[1]); pk.y = pk2(o[2], o[3]); pk.z = pk2(o[4], o[5]); pk.w = pk2(o[6], o[7]);
                        *(uint4*)&ACH[(tr * 4 + j) * AP + kg * 8] = pk;
                        if ((kg >> 2) == q) { float* xp = &XR32[(tr * 4 + j) * 32 + (kg & 3) * 8]; *(float4*)xp = make_float4(o[0], o[1], o[2], o[3]); *(float4*)(xp + 4) = make_float4(o[4], o[5], o[6], o[7]); } }
                }
                __syncthreads();
                {
                    f32x4 acc[4];
#pragma unroll
                    for (int nt = 0; nt < 4; ++nt) acc[nt] = (f32x4){0.f, 0.f, 0.f, 0.f};
#pragma unroll
                    for (int ks = 0; ks < 4; ++ks) { const bf16x8 a = *(const bf16x8*)&ACH[(wave * 16 + r16) * AP + ks * 32 + quad * 8];
#pragma unroll
                        for (int nt = 0; nt < 4; ++nt) { const bf16x8 b = *(const bf16x8*)&BT[(nt * 16 + r16) * AP + ks * 32 + quad * 8]; acc[nt] = __builtin_amdgcn_mfma_f32_16x16x32_bf16(a, b, acc[nt], 0, 0, 0); } }
#pragma unroll
                    for (int h2 = 0; h2 < 2; ++h2)
#pragma unroll
                        for (int j = 0; j < 4; ++j) { const int tl = wave * 16 + quad * 4 + j, cc = h2 * 16 + r16;
                            const float rg = sigmoidf_(acc[h2][j] + brv[h2]), ig = sigmoidf_(acc[2 + h2][j] + biv[h2]);
                            const float log_a = -rg * sp8[h2];
                            const float a = expf(log_a);
                            float mult = sqrtf(fmaxf(-expm1f(2.0f * log_a), 0.f));
                            if (isctx) { const int pos = (tbase + tl) & 255; if ((dir == 0 && pos == 0) || (dir == 1 && pos == 255)) mult = 1.0f; }
                            AB[tl * 64 + cc] = a; AB[tl * 64 + 32 + cc] = mult * ig * XR32[tl * 32 + cc]; }
                }
                __syncthreads();
                const int rank = dir ? 15 - seg : seg;
                {
                    float A = 1.f, B = 0.f;
#pragma unroll
                    for (int i = 0; i < 8; ++i) { const int tl = seg * 8 + (dir ? 7 - i : i); const float a = AB[tl * 64 + chain], b = AB[tl * 64 + 32 + chain]; B = a * B + b; A = A * a; }
                    SEG[(rank * 32 + chain) * 2] = A; SEG[(rank * 32 + chain) * 2 + 1] = B;
                }
                __syncthreads();
                {
                    const bool newseq = isctx && ((c & 1) == dir);
                    float h = newseq ? 0.f : CARRY[(ci & 1) * 32 + chain];
                    for (int rr = 0; rr < rank; ++rr) h = SEG[(rr * 32 + chain) * 2] * h + SEG[(rr * 32 + chain) * 2 + 1];
#pragma unroll
                    for (int i = 0; i < 8; ++i) { const int tl = seg * 8 + (dir ? 7 - i : i); const float a = AB[tl * 64 + chain], b = AB[tl * 64 + 32 + chain]; h = a * h + b;
                        const size_t tok = (size_t)(tbase + tl);
                        if (dir == 0) hf[tok * DRG + ch0 + chain] = h;
                        else { const float gy = bf2f(u[tok * 5120 + 1024 + ch0 + chain]); zrg[tok * DRG + ch0 + chain] = f2bf((hf[tok * DRG + ch0 + chain] + h) * gy); } }
                    if (rank == 15) { CARRY[((ci + 1) & 1) * 32 + chain] = h;
                        if (isctx && ((c & 1) != dir)) new_state[((size_t)((s * 4 + (c >> 1)) * DEPTH + layer) * 2 + dir) * DRG + ch0 + chain] = h; }
                }
            }
        }
    }
    __syncthreads();
}

#define XB_TMO      128
#define XB_XCNT(j)  (256  + 64 * (j))
#define XB_XSUB(j)  (1280 + 64 * (j))
#define XB_XGEN(j)  (2304 + 64 * (j))
#define XB_TOP      3328
#define XB_TOPGEN   3392
#define XCD_BAR_WORDS 3456
#define XB_SPIN_CAP (1u << 18)

__device__ __forceinline__ unsigned xb_ld(unsigned* p)              { return __hip_atomic_load(p, __ATOMIC_RELAXED, __HIP_MEMORY_SCOPE_AGENT); }
__device__ __forceinline__ unsigned xb_add(unsigned* p, unsigned v) { return __hip_atomic_fetch_add(p, v, __ATOMIC_RELAXED, __HIP_MEMORY_SCOPE_AGENT); }
__device__ __forceinline__ unsigned xb_xcc_id() { return (unsigned)__builtin_amdgcn_s_getreg((3 << 11) | 20) & 0xFu; }
#define XB_SPIN(cond, bar) do { unsigned _sp = 0; while (cond) { __builtin_amdgcn_s_sleep(1); \
    if ((++_sp & 255u) == 0u) { if (xb_ld(&(bar)[XB_TMO])) break; if (_sp > XB_SPIN_CAP) { atomicAdd(&(bar)[XB_TMO], 1u); break; } } } } while (0)

struct XcdBarrier {
    unsigned* bar; unsigned x;
    volatile LAS unsigned* st;
};

__device__ __forceinline__ XcdBarrier xcd_barrier_post(unsigned* bar, volatile LAS unsigned* st) {
    XcdBarrier b; b.bar = bar; b.x = xb_xcc_id(); b.st = st;
    if (threadIdx.x == 0) (void)xb_add(&bar[XB_XCNT(b.x)], 1u);
    return b;
}
__device__ __forceinline__ void xcd_barrier_complete(unsigned* bar, unsigned x, unsigned& nloc, unsigned& nx) {
    const unsigned G = gridDim.x * gridDim.y * gridDim.z;
    unsigned sum, cnt, mine, sp = 0u;
    for (;;) {
        sum = 0u; cnt = 0u; mine = 0u;
#pragma unroll
        for (unsigned j = 0; j < 16; ++j) { const unsigned c = xb_ld(&bar[XB_XCNT(j)]); sum += c; cnt += (c > 0u) ? 1u : 0u; mine = (j == x) ? c : mine; }
        if (sum == G) break;
        __builtin_amdgcn_s_sleep(1);
        if ((++sp & 255u) == 0u) { if (xb_ld(&bar[XB_TMO])) break; if (sp > XB_SPIN_CAP) { atomicAdd(&bar[XB_TMO], 1u); break; } }
    }
    nloc = mine > 0u ? mine : 1u; nx = cnt > 0u ? cnt : 1u;
}

__device__ __forceinline__ void xcd_barrier(const XcdBarrier& b) {
    asm volatile("s_waitcnt vmcnt(0)" ::: "memory");
    __syncthreads();
    if (threadIdx.x == 0) {
        unsigned* bar = b.bar;
        __builtin_amdgcn_s_waitcnt(0);
        unsigned nloc = b.st[0], nx = b.st[1];
        if (nloc == 0u) { xcd_barrier_complete(bar, b.x, nloc, nx); b.st[0] = nloc; b.st[1] = nx; }
        const unsigned old = xb_add(&bar[XB_XSUB(b.x)], 1u);
        const unsigned gen = old / nloc;
        if (old + 1u == (gen + 1u) * nloc) {
            __builtin_amdgcn_fence(__ATOMIC_RELEASE, "agent");
            asm volatile("s_waitcnt vmcnt(0)" ::: "memory");
            const unsigned og = xb_add(&bar[XB_TOP], 1u);
            const unsigned tg = og / nx;
            if (og + 1u == (tg + 1u) * nx) xb_add(&bar[XB_TOPGEN], 1u);
            else XB_SPIN(xb_ld(&bar[XB_TOPGEN]) == tg, bar);
            __builtin_amdgcn_fence(__ATOMIC_ACQUIRE, "agent");
            xb_add(&bar[XB_XGEN(b.x)], 1u);
            asm volatile("s_waitcnt vmcnt(0)" ::: "memory");
        } else {
            XB_SPIN(xb_ld(&bar[XB_XGEN(b.x)]) == gen, bar);
            __builtin_amdgcn_fence(__ATOMIC_ACQUIRE, "agent");
            asm volatile("s_waitcnt vmcnt(0)" ::: "memory");
        }
    }
    __syncthreads();
}

struct Params { const float* in[33]; float* out; unsigned char* ws; };
constexpr int LDS_BYTES = 147456;
constexpr size_t MiB = (size_t)1 << 20;
constexpr size_t WS_CTL = 12 * MiB, CTL_BYTES = 65536, WS_MOD = 0, WS_H2 = 2 * MiB, WS_X = 13 * MiB, WS_XN = 45 * MiB, WS_MF = 61 * MiB, WS_ZHY = 93 * MiB, WS_ZFN = 101 * MiB, WS_ZRG = 109 * MiB,
                 WS_W = 125 * MiB, WS_DFTC = 163 * MiB, WS_DFTL = 164 * MiB, WS_BIG = 168 * MiB, WS_RT = 288 * MiB, WS_END = WS_RT + 20 * MiB;
constexpr size_t WO_IN = 0, WO_A = WO_IN + (size_t)7680 * D, WO_B = WO_A + (size_t)D * 512, WO_C = WO_B + (size_t)D * 512, WO_O = WO_C + (size_t)D * D, WO_GU = WO_O + (size_t)D * D, WO_D = WO_GU + (size_t)2 * DFF * D, WO_END = WO_D + (size_t)D * DFF;
static_assert(WO_END * 2 <= 38 * MiB, "weight copies");

#define GEMM_PHASE(EpiT, g, E, ALIGN) do { pg8::StaticOrder S_; S_.init((g).M, (g).N, opq_s((int)gridDim.x), opq_s((int)blockIdx.x)); pg8::gemm_phase<EpiT, pg8::StaticOrder, ALIGN, true>(ldsp, g, S_, E); } while (0)

constexpr int PROBE_REPS[16] = {1,1,1,1,1,1,1,1,1,1,1,1,1,1,1,1};
#define REP(k) for (int rep_ = PROBE_REPS[k] - 1; rep_ >= 0; --rep_)
#define GSYNC() do { for (int rep_ = 0; rep_ < PROBE_REPS[13]; ++rep_) xcd_barrier(xbar); } while (0)
#define IN(i) (p.in[opq_s(i)])
#define WSB(off) (p.ws + (size_t)opq_s((int)((off) >> 20)) * MiB)
__global__ void __launch_bounds__(512, 2) mega(Params p) {
    cg::grid_group grid = cg::this_grid();
    extern __shared__ __attribute__((aligned(16))) unsigned char lds[];
    PG8_LAS unsigned char* ldsp = (PG8_LAS unsigned char*)lds;
    volatile LAS unsigned* bar_st = (volatile LAS unsigned*)((LAS unsigned char*)lds + (LDS_BYTES - 64));
    if (threadIdx.x < 16) bar_st[threadIdx.x] = 0u;
    __syncthreads();
    const XcdBarrier xbar = xcd_barrier_post((unsigned*)(p.ws + WS_CTL), bar_st);
#define P_X      ((float*)WSB(WS_X))
#define P_XN     ((bf16_t*)WSB(WS_XN))
#define P_MF     ((float*)WSB(WS_MF))
#define P_ZHY    ((bf16_t*)WSB(WS_ZHY))
#define P_ZFN    ((bf16_t*)WSB(WS_ZFN))
#define P_ZRG    ((bf16_t*)WSB(WS_ZRG))
#define P_WL     ((bf16_t*)WSB(WS_W))
#define P_UT     ((bf16_t*)WSB(WS_BIG))
#define P_U2     ((bf16_t*)WSB(WS_BIG + 24 * MiB))
#define P_BTC    ((bf16_t*)WSB(WS_BIG + 104 * MiB))
#define P_BTL    ((bf16_t*)WSB(WS_BIG + 112 * MiB))
#define P_RT     ((bf16_t*)WSB(WS_RT))
#define P_DFTC   ((bf16_t*)WSB(WS_DFTC))
#define P_DFTL   ((bf16_t*)WSB(WS_DFTL))
#define P_MOD    ((float*)WSB(WS_MOD))
#define P_H2     ((float*)WSB(WS_H2))
#define P_GB     (p.out)
#define P_NS     (p.out + (size_t)2 * MCTX * D)
    { PHASE_IDS
      float* x = P_X; const float* xp = IN(0); const float* xs = IN(1);
      GRID_LOOP(i, (long)MCTX * D / 4) ((float4*)x)[i] = ((const float4*)xp)[i];
      GRID_LOOP(i, (long)MLAT * D / 4) ((float4*)(x + (size_t)MCTX * D))[i] = ((const float4*)xs)[i]; }
    REP(14) d_mod(lds, IN(2), IN(4), IN(7), IN(8), P_MOD);
    REP(0) d_dftmat(P_DFTC, P_DFTL);
    for (int l0 = 0; l0 < DEPTH; ++l0) { const int l = opq_s(l0); d_filt_h2((float*)lds, IN(12) + l * 17 * 64, IN(13) + l * 64, IN(14) + l * 64 * 64, IN(15) + l * 64, IN(17) + l * 64, P_H2 + (size_t)l * 1280 * 64); }
    grid.sync();
    REP(15) d_filt_h3T(lds, P_H2, IN(16), (float*)WSB(WS_BIG));
    GSYNC();
    REP(12) for (int l0 = 0; l0 < DEPTH; ++l0) { const int l = opq_s(l0); d_filt_build((const float*)WSB(WS_BIG) + (size_t)l * 2048 * 1280, P_RT + (size_t)l * RT_LAYER); }
    GSYNC();
    for (int l0 = 0; l0 < DEPTH; ++l0) {
        const int l = opq_s(l0);
        REP(1) { { bf16_t* wl = P_WL; const LayerW LW{wl + WO_IN, wl + WO_A, wl + WO_B, wl + WO_C, wl + WO_O, wl + WO_GU, wl + WO_D};
          d_convert(lds, IN(9) + (size_t)l * D * DIN, IN(19) + (size_t)l * 512 * D, IN(20) + (size_t)l * 512 * D, IN(28) + (size_t)l * D * D, IN(29) + (size_t)l * D * D, IN(30) + (size_t)l * D * 2 * DFF, IN(31) + (size_t)l * DFF * D, LW); }
        __syncthreads();
        d_fold_fnet(lds, IN(9) + (size_t)l * D * DIN, P_WL + WO_IN); }
        REP(2) d_norm(P_X, IN(5) + l * D, P_MOD + (size_t)l * 5 * NMOD, 0, D, P_XN);
        GSYNC();
        REP(3) { const pg8::Gemm g{P_WL + WO_IN, P_XN, 2560, MTOK, D}; const pg8::EpiG1a E{P_UT, P_BTC, P_BTL}; GEMM_PHASE(pg8::EpiG1a, g, E, true); }
        REP(4) { const pg8::Gemm g{P_XN, P_WL + WO_IN + (size_t)2560 * D, MTOK, 5120, D}; const pg8::EpiG1b E{P_U2, 0, 0}; GEMM_PHASE(pg8::EpiG1b, g, E, true); }
        GSYNC();
        REP(5) d_hyena(lds, P_UT, IN(10) + l * 3 * 1536, IN(11) + l * 1536, IN(18) + l * 1024, P_RT + (size_t)l * RT_LAYER, P_ZHY);
        REP(6) d_rg_fast(lds, P_U2, IN(21) + l * 4 * 1024, IN(22) + l * 1024, IN(23) + (size_t)l * 2 * 8 * 128 * 128, IN(24) + l * 2048, IN(25) + (size_t)l * 2 * 8 * 128 * 128, IN(26) + l * 2048, IN(27) + l * 2048, IN(3), l, P_MF, P_ZRG, P_NS);
        REP(7) { { const pg8::Gemm g{P_DFTC, P_BTC, 256, 8192, 512}; const pg8::EpiFnet E{P_ZFN, 256, 0}; GEMM_PHASE(pg8::EpiFnet, g, E, false); }
        { const pg8::Gemm g{P_DFTL, P_BTL, 1024, 2048, 2048}; const pg8::EpiFnet E{P_ZFN, 1024, MCTX}; pg8::StaticOrder S_; S_.init(1024, 2048, opq_s((int)gridDim.x), (opq_s((int)blockIdx.x) + (int)gridDim.x - 32) % (int)gridDim.x); pg8::gemm_phase<pg8::EpiFnet, pg8::StaticOrder, false, true>(ldsp, g, S_, E); } }
        GSYNC();
        REP(8) { { const pg8::Gemm g{P_ZHY, P_WL + WO_A, MTOK, D, 512}; const pg8::EpiMerge E{P_MF, P_XN, P_U2, 0, 0}; GEMM_PHASE(pg8::EpiMerge, g, E, false); }
        { const pg8::Gemm g{P_ZFN, P_WL + WO_B, MTOK, D, 512}; const pg8::EpiMerge E{P_MF, P_XN, P_U2, 1, 1}; GEMM_PHASE(pg8::EpiMerge, g, E, false); }
        { const pg8::Gemm g{P_ZRG, P_WL + WO_C, MTOK, D, D}; const pg8::EpiMerge E{P_MF, P_XN, P_U2, 2, 2}; GEMM_PHASE(pg8::EpiMerge, g, E, false); } }
        GSYNC();
        REP(9) { const pg8::Gemm g{P_XN, P_WL + WO_O, MTOK, D, D}; const pg8::EpiResid E{P_X, rep_ ? P_MF : P_X, P_MOD + (size_t)l * 5 * NMOD + 2 * D, NMOD, 0}; GEMM_PHASE(pg8::EpiResid, g, E, false); }
        GSYNC();
        REP(10) d_norm(P_X, IN(6) + l * D, P_MOD + (size_t)l * 5 * NMOD, 3 * D, 4 * D, P_XN);
        GSYNC();
        REP(11) { const pg8::Gemm g{P_XN, P_WL + WO_GU, MTOK, 2 * DFF, D}; const pg8::EpiSwiglu E{P_U2, DFF, 0}; GEMM_PHASE(pg8::EpiSwiglu, g, E, true); }
        GSYNC();
        REP(12) { const pg8::Gemm g{P_U2, P_WL + WO_D, MTOK, D, DFF}; const pg8::EpiResid E{P_X, rep_ ? P_MF : P_X, P_MOD + (size_t)l * 5 * NMOD + 5 * D, NMOD, 0}; GEMM_PHASE(pg8::EpiResid, g, E, false); }
        GSYNC();
    }
    d_final(P_X, IN(32), p.out);
}

extern "C" void kernel_launch(void* const* d_in, const int* in_sizes, int n_in, void* d_out, int out_size, void* d_ws, size_t ws_size, hipStream_t stream) {
    static int grid_blocks = 0;
    if (grid_blocks == 0) {
        if (n_in != 33 || ws_size < WS_END) { fprintf(stderr, "kernel_launch: unexpected n_in %d or ws_size %zu (need %zu)\n", n_in, ws_size, (size_t)WS_END); grid_blocks = -1; return; }
        int dev = 0, cus = 0, per_cu = 0;
        (void)hipGetDevice(&dev);
        (void)hipDeviceGetAttribute(&cus, hipDeviceAttributeMultiprocessorCount, dev);
        (void)hipFuncSetAttribute((const void*)mega, hipFuncAttributeMaxDynamicSharedMemorySize, LDS_BYTES);
        (void)hipOccupancyMaxActiveBlocksPerMultiprocessor(&per_cu, (const void*)mega, 512, LDS_BYTES);
        if (per_cu < 1 || cus < 1) { fprintf(stderr, "kernel_launch: occupancy query gave %d blocks/CU on %d CUs\n", per_cu, cus); grid_blocks = -1; return; }
        grid_blocks = cus * per_cu;
    }
    if (grid_blocks < 0) return;
    if (hipMemsetAsync((char*)d_ws + WS_CTL, 0, CTL_BYTES, stream) != hipSuccess) { fprintf(stderr, "kernel_launch: memset of the barrier words failed\n"); return; }
    Params p{};
    for (int i = 0; i < 33; ++i) p.in[i] = (const float*)d_in[i];
    p.out = (float*)d_out; p.ws = (unsigned char*)d_ws;
    void* args[] = {&p};
    hipError_t e = hipLaunchCooperativeKernel((const void*)mega, dim3(grid_blocks), dim3(512), args, LDS_BYTES, stream);
    if (e != hipSuccess) fprintf(stderr, "cooperative launch failed: %s (grid %d)\n", hipGetErrorString(e), grid_blocks);
}
```
